# Optimizing an MI355X kernel written in HIP

```python
import math
import jax, jax.numpy as jnp
from jax import lax
import numpy as np

D_MODEL = 1024
BATCH = 4
SEQ = 8192
DEPTH = 1
DEC_BATCH = 8
DEC_SEQ = 32
PAST_LEN = 4096

CHUNK = 64
D_MIX = D_MODEL
D_ATT = D_MIX // 2
D_LRU = D_MIX - D_ATT
N_HEADS_A = 4
D_HEAD_V = D_ATT // N_HEADS_A
D_HEAD_QK = D_HEAD_V // 2
N_BLOCKS_LRU = 8
D_BLOCK_LRU = D_LRU // N_BLOCKS_LRU
CONV_W = 4
LRU_C = 8.0
D_FF = 2816
Q_BLOCK = 128
RMS_EPS = 1e-6
D_IN = 3 * D_ATT + 2 * D_LRU
NEG_INF = -1e30

kernel_name = "hybrid_diffattn_rglru_streaming_step"


def rmsnorm(x, g):
    xf = x.astype(jnp.float32)
    y = xf * lax.rsqrt(jnp.mean(xf * xf, axis=-1, keepdims=True) + RMS_EPS)
    return (y * g.astype(jnp.float32)).astype(x.dtype)


def swiglu(x, w_gate, w_up, w_down):
    return (jax.nn.silu(x @ w_gate) * (x @ w_up)) @ w_down


def alibi_slopes():
    return jnp.asarray(2.0 ** (-8.0 * np.arange(1, N_HEADS_A + 1) / N_HEADS_A), dtype=jnp.float32)


def diff_attn_core(q, k, v, q_pos, k_pos, lam):
    scale = 1.0 / math.sqrt(D_HEAD_QK)
    s = jnp.einsum('bqhcd,bkhcd->bhcqk', q.astype(jnp.float32), k.astype(jnp.float32)) * scale
    dist = jnp.abs(q_pos[:, None] - k_pos[None, :]).astype(jnp.float32)
    bias = -alibi_slopes()[None, :, None, None, None] * dist[None, None, None]
    mask = (q_pos[:, None] // CHUNK) >= (k_pos[None, :] // CHUNK)
    s = jnp.where(mask[None, None, None], s + bias, NEG_INF)
    p = jax.nn.softmax(s, axis=-1)
    p = p[:, :, 0] - lam * p[:, :, 1]
    return jnp.einsum('bhqk,bkhd->bqhd', p, v.astype(jnp.float32))


def diff_attn_prompt(q, k, v, lam):
    B, T = q.shape[0], q.shape[1]
    nb = T // Q_BLOCK
    qb = q.reshape(B, nb, Q_BLOCK, N_HEADS_A, 2, D_HEAD_QK).swapaxes(0, 1)
    pb = jnp.arange(T, dtype=jnp.int32).reshape(nb, Q_BLOCK)
    kpos = jnp.arange(T, dtype=jnp.int32)
    o = lax.map(lambda a: diff_attn_core(a[0], k, v, a[1], kpos, lam), (qb, pb))
    return o.swapaxes(0, 1).reshape(B, T, N_HEADS_A, D_HEAD_V)


def causal_conv(x, buf, w, b):
    T = x.shape[1]
    xp = jnp.concatenate([buf.astype(x.dtype), x], axis=1)
    y = b + sum(xp[:, j:j + T] * w[j] for j in range(CONV_W))
    return y, xp[:, -(CONV_W - 1):]


def block_diag(x, w, b):
    B, T = x.shape[0], x.shape[1]
    xb = x.reshape(B, T, N_BLOCKS_LRU, D_BLOCK_LRU)
    return jnp.einsum('btnc,ncd->btnd', xb, w).reshape(B, T, D_LRU) + b


def rglru(x, h0, w_r, b_r, w_i, b_i, lru_lambda):
    xf = x.astype(jnp.float32)
    r = jax.nn.sigmoid(block_diag(xf, w_r.astype(jnp.float32), b_r.astype(jnp.float32)))
    i = jax.nn.sigmoid(block_diag(xf, w_i.astype(jnp.float32), b_i.astype(jnp.float32)))
    log_a = -LRU_C * r * jax.nn.softplus(-lru_lambda.astype(jnp.float32))
    a = jnp.exp(log_a)
    bx = jnp.sqrt(-jnp.expm1(2.0 * log_a)) * (i * xf)
    bx = bx.at[:, 0].add(a[:, 0] * h0.astype(jnp.float32))

    def combine(c1, c2):
        a1, b1 = c1
        a2, b2 = c2
        return a1 * a2, a2 * b1 + b2

    _, h = lax.associative_scan(combine, (a, bx), axis=1)
    return h.astype(x.dtype), h[:, -1].astype(x.dtype)


def mixer(xn, past_k, past_v, h0, conv_buf, w_in, w_out, lq1, lk1, lq2, lk2, subln_g,
          conv_w, conv_b, w_rg, b_rg, w_ig, b_ig, lru_lambda, lambda_init):
    B, T = xn.shape[0], xn.shape[1]
    proj = xn @ w_in
    q = proj[..., :D_ATT].reshape(B, T, N_HEADS_A, 2, D_HEAD_QK)
    k = proj[..., D_ATT:2 * D_ATT].reshape(B, T, N_HEADS_A, 2, D_HEAD_QK)
    v = proj[..., 2 * D_ATT:3 * D_ATT].reshape(B, T, N_HEADS_A, D_HEAD_V)
    lru_x = proj[..., 3 * D_ATT:3 * D_ATT + D_LRU]
    lru_gate = proj[..., 3 * D_ATT + D_LRU:]
    lam = (jnp.exp(jnp.sum(lq1.astype(jnp.float32) * lk1.astype(jnp.float32)))
           - jnp.exp(jnp.sum(lq2.astype(jnp.float32) * lk2.astype(jnp.float32))) + lambda_init)
    if past_k is None:
        o = diff_attn_prompt(q, k, v, lam)
    else:
        P = past_k.shape[1]
        k_all = jnp.concatenate([past_k.astype(k.dtype), k], axis=1)
        v_all = jnp.concatenate([past_v.astype(v.dtype), v], axis=1)
        q_pos = P + jnp.arange(T, dtype=jnp.int32)
        k_pos = jnp.arange(P + T, dtype=jnp.int32)
        o = diff_attn_core(q, k_all, v_all, q_pos, k_pos, lam)
    o = rmsnorm(o, subln_g) * (1.0 - lambda_init)
    att_out = o.reshape(B, T, D_ATT).astype(xn.dtype)
    xc, new_buf = causal_conv(lru_x, conv_buf, conv_w, conv_b)
    h, h_last = rglru(xc, h0, w_rg, b_rg, w_ig, b_ig, lru_lambda)
    lru_out = h * jax.nn.gelu(lru_gate, approximate=True)
    out = jnp.concatenate([att_out, lru_out], axis=-1) @ w_out
    return out, k, v, h_last, new_buf


def layer(x, past_k, past_v, h0, conv_buf, lp, lambda_init):
    (w_in, w_out, lq1, lk1, lq2, lk2, subln_g, conv_w, conv_b, w_rg, b_rg, w_ig, b_ig, lru_lambda,
     f1g, f1u, f1d, f2g, f2u, f2d, g1a, g1b, gma, gmb, g2a, g2b) = lp
    x = x + 0.5 * rmsnorm(swiglu(rmsnorm(x, g1a), f1g, f1u, f1d), g1b)
    m, k_new, v_new, h_last, new_buf = mixer(rmsnorm(x, gma), past_k, past_v, h0, conv_buf, w_in, w_out,
                                             lq1, lk1, lq2, lk2, subln_g, conv_w, conv_b, w_rg, b_rg,
                                             w_ig, b_ig, lru_lambda, lambda_init)
    x = x + rmsnorm(m, gmb)
    x = x + 0.5 * rmsnorm(swiglu(rmsnorm(x, g2a), f2g, f2u, f2d), g2b)
    return x, k_new, v_new, h_last, new_buf


def setup_inputs(seed: int = 0) -> dict:
    key = jax.random.key(seed)
    ks = iter(jax.random.split(key, 40))
    f32 = jnp.float32

    def nrm(shape, scale):
        return jax.random.normal(next(ks), shape, f32) * scale

    def gain():
        return jnp.ones((DEPTH, D_MODEL), f32) + nrm((DEPTH, D_MODEL), 0.01)

    a_init = jax.random.uniform(next(ks), (DEPTH, D_LRU), f32, 0.9, 0.999)
    s_init = a_init ** (1.0 / LRU_C)
    lru_lambda = jnp.log(s_init) - jnp.log1p(-s_init)
    return {
        "x_prompt": nrm((BATCH, SEQ, D_MODEL), 1.0),
        "x_sample": nrm((DEC_BATCH, DEC_SEQ, D_MODEL), 1.0),
        "cache_k": nrm((DEPTH, DEC_BATCH, PAST_LEN, N_HEADS_A, 2, D_HEAD_QK), 1.0),
        "cache_v": nrm((DEPTH, DEC_BATCH, PAST_LEN, N_HEADS_A, D_HEAD_V), 1.0),
        "state_lru_h": nrm((DEPTH, DEC_BATCH, D_LRU), 0.5),
        "state_conv": nrm((DEPTH, DEC_BATCH, CONV_W - 1, D_LRU), 1.0),
        "w_in": nrm((DEPTH, D_MODEL, D_IN), D_MODEL ** -0.5),
        "w_out": nrm((DEPTH, D_MIX, D_MODEL), D_MIX ** -0.5),
        "lambda_q1": nrm((DEPTH, D_HEAD_QK), 0.1),
        "lambda_k1": nrm((DEPTH, D_HEAD_QK), 0.1),
        "lambda_q2": nrm((DEPTH, D_HEAD_QK), 0.1),
        "lambda_k2": nrm((DEPTH, D_HEAD_QK), 0.1),
        "subln_g": jnp.ones((DEPTH, D_HEAD_V), f32) + nrm((DEPTH, D_HEAD_V), 0.01),
        "conv_w": nrm((DEPTH, CONV_W, D_LRU), CONV_W ** -0.5),
        "conv_b": nrm((DEPTH, D_LRU), 0.01),
        "w_rgate": nrm((DEPTH, N_BLOCKS_LRU, D_BLOCK_LRU, D_BLOCK_LRU), D_BLOCK_LRU ** -0.5),
        "b_rgate": nrm((DEPTH, D_LRU), 0.01),
        "w_igate": nrm((DEPTH, N_BLOCKS_LRU, D_BLOCK_LRU, D_BLOCK_LRU), D_BLOCK_LRU ** -0.5),
        "b_igate": nrm((DEPTH, D_LRU), 0.01),
        "lru_lambda": lru_lambda,
        "ffn1_w_gate": nrm((DEPTH, D_MODEL, D_FF), D_MODEL ** -0.5),
        "ffn1_w_up": nrm((DEPTH, D_MODEL, D_FF), D_MODEL ** -0.5),
        "ffn1_w_down": nrm((DEPTH, D_FF, D_MODEL), D_FF ** -0.5),
        "ffn2_w_gate": nrm((DEPTH, D_MODEL, D_FF), D_MODEL ** -0.5),
        "ffn2_w_up": nrm((DEPTH, D_MODEL, D_FF), D_MODEL ** -0.5),
        "ffn2_w_down": nrm((DEPTH, D_FF, D_MODEL), D_FF ** -0.5),
        "g_ffn1_pre": gain(),
        "g_ffn1_post": gain(),
        "g_mix_pre": gain(),
        "g_mix_post": gain(),
        "g_ffn2_pre": gain(),
        "g_ffn2_post": gain(),
    }


def reference(x_prompt, x_sample, cache_k, cache_v, state_lru_h, state_conv, w_in, w_out,
              lambda_q1, lambda_k1, lambda_q2, lambda_k2, subln_g, conv_w, conv_b,
              w_rgate, b_rgate, w_igate, b_igate, lru_lambda,
              ffn1_w_gate, ffn1_w_up, ffn1_w_down, ffn2_w_gate, ffn2_w_up, ffn2_w_down,
              g_ffn1_pre, g_ffn1_post, g_mix_pre, g_mix_post, g_ffn2_pre, g_ffn2_post):
    xp, xs = x_prompt, x_sample
    kp_l, vp_l, hp_l, cp_l, ks_l, vs_l, hs_l, cs_l = [], [], [], [], [], [], [], []
    for l in range(DEPTH):
        lambda_init = 0.8 - 0.6 * math.exp(-0.3 * l)
        lp = (w_in[l], w_out[l], lambda_q1[l], lambda_k1[l], lambda_q2[l], lambda_k2[l], subln_g[l],
              conv_w[l], conv_b[l], w_rgate[l], b_rgate[l], w_igate[l], b_igate[l], lru_lambda[l],
              ffn1_w_gate[l], ffn1_w_up[l], ffn1_w_down[l], ffn2_w_gate[l], ffn2_w_up[l], ffn2_w_down[l],
              g_ffn1_pre[l], g_ffn1_post[l], g_mix_pre[l], g_mix_post[l], g_ffn2_pre[l], g_ffn2_post[l])
        h0_p = jnp.zeros((xp.shape[0], D_LRU), xp.dtype)
        buf_p = jnp.zeros((xp.shape[0], CONV_W - 1, D_LRU), xp.dtype)
        xp, k_p, v_p, h_p, c_p = layer(xp, None, None, h0_p, buf_p, lp, lambda_init)
        xs, k_s, v_s, h_s, c_s = layer(xs, cache_k[l], cache_v[l], state_lru_h[l], state_conv[l], lp, lambda_init)
        kp_l.append(k_p); vp_l.append(v_p); hp_l.append(h_p); cp_l.append(c_p)
        ks_l.append(k_s); vs_l.append(v_s); hs_l.append(h_s); cs_l.append(c_s)
    k_prompt = jnp.stack(kp_l); v_prompt = jnp.stack(vp_l)
    lru_h_prompt = jnp.stack(hp_l); conv_prompt = jnp.stack(cp_l)
    k_sample = jnp.stack(ks_l); v_sample = jnp.stack(vs_l)
    lru_h_sample = jnp.stack(hs_l); conv_sample = jnp.stack(cs_l)
    return (xp, xs, k_prompt, v_prompt, lru_h_prompt, conv_prompt, k_sample, v_sample, lru_h_sample, conv_sample)
```

```cpp
#include <hip/hip_runtime.h>
#include <hip/hip_cooperative_groups.h>
#include <cstdio>
namespace cg = cooperative_groups;

#define LAS __attribute__((address_space(3)))
#define DI __device__ __forceinline__
typedef unsigned short bf16_t;
typedef short bf16x8 __attribute__((ext_vector_type(8)));
typedef float f32x2 __attribute__((ext_vector_type(2)));
typedef float f32x4 __attribute__((ext_vector_type(4)));
typedef float f32x16 __attribute__((ext_vector_type(16)));
typedef unsigned u32x2 __attribute__((ext_vector_type(2)));
typedef unsigned u32x4 __attribute__((ext_vector_type(4)));
typedef __bf16 bf16x2n __attribute__((ext_vector_type(2)));

constexpr int DM = 1024, TP = 8192, NBP = 4, NBS = 8, TSQ = 32, PAST = 4096, DFF = 2816, DIN = 2560;
constexpr int MP = NBP * TP, MS = NBS * TSQ, MT = MP + MS;
constexpr int TSP = 4160;
constexpr int NTHREADS = 512;
constexpr int LDS_CTL = 139264;
constexpr int LDS_BYTES = LDS_CTL + 64;
constexpr float RMS_EPS = 1e-6f;
constexpr float LOG2E = 1.4426950408889634f;

constexpr size_t SZ_H = (size_t)MT * DFF * 2, SZ_D = (size_t)MT * DM * 4, SZ_XN = (size_t)MT * DM * 2;
constexpr size_t WS_A = 0;
constexpr size_t WS_B = WS_A + SZ_H;
constexpr size_t WS_C = WS_B + SZ_D;
constexpr size_t WS_W = WS_C + SZ_XN;
constexpr size_t SZ_WGU = (size_t)2 * DFF * DM * 2, SZ_WD = (size_t)DM * DFF * 2, SZ_WIN = (size_t)DIN * DM * 2, SZ_WOUT = (size_t)DM * DM * 2, SZ_WG = (size_t)64 * 512 * 2;
constexpr size_t WS_WGU1 = WS_W, WS_WD1 = WS_WGU1 + SZ_WGU, WS_WIN = WS_WD1 + SZ_WD, WS_WOUT = WS_WIN + SZ_WIN, WS_WGU2 = WS_WOUT + SZ_WOUT, WS_WD2 = WS_WGU2 + SZ_WGU;
constexpr size_t WS_WRT = WS_WD2 + SZ_WD, WS_WIT = WS_WRT + SZ_WG;
constexpr size_t WS_PP = WS_WIT + SZ_WG;
constexpr size_t WS_HL = WS_PP + (size_t)MT * 512 * 2;
constexpr size_t WS_AP = WS_HL + (size_t)MT * 512 * 2;
constexpr size_t WS_HE = WS_AP + (size_t)12 * 128 * 512 * 4;
constexpr size_t WS_KNP = WS_HE + (size_t)12 * 128 * 512 * 4;
constexpr size_t WS_KNS = WS_KNP + (size_t)NBP * 4 * 2 * 128 * 4;
constexpr size_t WS_CNT = WS_KNS + (size_t)NBS * 4 * 2 * 128 * 4;
constexpr size_t WS_CAR = WS_CNT + 256;
constexpr size_t WS_BAR = WS_CAR + (size_t)NBP * 128 * 512 * 4;
constexpr size_t WS_END = WS_BAR + 16384;
constexpr size_t WS_Q = WS_A, WS_KP = WS_Q + (size_t)MT * 512 * 2, WS_KS = WS_KP + (size_t)MP * 512 * 2, WS_VTP = WS_KS + (size_t)NBS * TSP * 512 * 2, WS_VTS = WS_VTP + (size_t)MP * 512 * 2;
static_assert(WS_VTS + (size_t)NBS * 512 * TSP * 2 <= WS_B, "region A overflow");
constexpr size_t WS_LX = WS_B, WS_GG = WS_LX + (size_t)MT * 512 * 4;
static_assert(WS_GG + (size_t)MT * 512 * 2 <= WS_C, "region B overflow");

constexpr size_t OUT_Y = 0, OUT_KP = (size_t)MT * DM, OUT_VP = OUT_KP + (size_t)MP * 512, OUT_LHP = OUT_VP + (size_t)MP * 512, OUT_CVP = OUT_LHP + NBP * 512,
                 OUT_KS = OUT_CVP + NBP * 3 * 512, OUT_VS = OUT_KS + (size_t)MS * 512, OUT_LHS = OUT_VS + (size_t)MS * 512, OUT_CVS = OUT_LHS + NBS * 512;

struct Params { const float* in[32]; float* out; unsigned char* ws; int ph_lo, ph_hi; };

enum { I_XP = 0, I_XS, I_CK, I_CV, I_SH, I_SC, I_WIN, I_WOUT, I_LQ1, I_LK1, I_LQ2, I_LK2, I_SUBG, I_CW, I_CB, I_WR, I_BR, I_WI, I_BI, I_LAM,
       I_F1G, I_F1U, I_F1D, I_F2G, I_F2U, I_F2D, I_G1A, I_G1B, I_GMA, I_GMB, I_G2A, I_G2B };

DI int vpos(int tl) { return (tl & ~12) | ((tl & 4) << 1) | ((tl & 8) >> 1); }
DI int phase_tid() { int t = threadIdx.x; asm volatile("" : "+v"(t)); return t; }
DI unsigned pk_bf16(float a, float b) { f32x2 v = {a, b}; bf16x2n r = __builtin_convertvector(v, bf16x2n); return __builtin_bit_cast(unsigned, r); }
DI float bf2f(bf16_t v) { return __uint_as_float(((unsigned)v) << 16); }
DI float wave_sum(float v) {
#pragma unroll
    for (int o = 32; o >= 1; o >>= 1) v += __shfl_xor(v, o);
    return v; }
DI float sigmoidf_(float x) { return __builtin_amdgcn_rcpf(1.0f + __expf(-x)); }
DI float gelu_tanh(float x) { const float u = 0.7978845608028654f * (x + 0.044715f * x * x * x); return x * __builtin_amdgcn_rcpf(1.0f + __expf(-2.0f * u)); }

namespace pg8 {
constexpr int BM = 256, BK = 64, HALF = 128, HTB = HALF * BK * 2, STAGE_BYTES = 8 * HTB, NXCD = 8, WGM = 8;
DI int lds_byte(int r, int c) { const int st = (r >> 4) * 2 + (c >> 5), rr = r & 15, cc = c & 31, ob = rr * 64 + cc * 2; return st * 1024 + (ob ^ (((ob >> 9) & 1) << 5)); }
DI void stage_rc(int b, int& R, int& C) { const int st = b / 1024, sb = b % 1024, swz = sb ^ (((sb >> 9) & 1) << 5); R = (st >> 1) * 16 + swz / 64; C = (st & 1) * 32 + (swz % 64) / 2; }
DI int perm32(int rho) { const int n = rho >> 4, i = rho & 15; return 8 * (i >> 2) + 4 * n + (i & 3); }
struct Unit { int pm, pn, k0, nt, part; };
struct Gemm { const bf16_t* A; const bf16_t* Bt; int M, N, K; };
struct StaticOrder {
    int nM, nN, nwg, G, c, ntk;
    DI void init(int M, int N, int K, int G_, int c_) { nM = M / BM; nN = N / BM; nwg = nM * nN; G = G_; c = c_; ntk = K / BK; }
    DI bool next(int i, Unit& u) const {
        const long L = (long)i * G + c; if (L >= nwg) return false;
        int wgid = (int)L; { const int q = nwg / NXCD, r = nwg % NXCD, xcd = wgid % NXCD, off = wgid / NXCD; wgid = (xcd < r ? xcd * (q + 1) : r * (q + 1) + (xcd - r) * q) + off; }
        const int nig = WGM * nN, gid = wgid / nig, fm = gid * WGM, gsz = (nM - fm) < WGM ? (nM - fm) : WGM;
        u.pm = fm + ((wgid % nig) % gsz); u.pn = (wgid % nig) / gsz; u.k0 = 0; u.nt = ntk; u.part = -1; return true;
    }
    DI void a_ready(const Unit&) const {}
    DI void done(const Unit&) const {}
};
struct SplitOrder {
    StaticOrder P; int nN, ksplit, ntc, G, c;
    DI void init(int N, int K, int ksplit_, int G_, int c_) { P.init(MP, N, K, G_, c_); nN = N / BM; ksplit = ksplit_; ntc = K / BK / ksplit_; G = G_; c = c_; }
    DI bool next(int i, Unit& u) const {
        const long L = (long)i * G + c;
        if (L < P.nwg) return P.next(i, u);
        const int j = (int)(L - P.nwg); if (j >= nN * ksplit) return false;
        const int ks = j / nN; u.pm = MP / BM; u.pn = j % nN; u.k0 = ks * ntc * BK; u.nt = ntc; u.part = ks; return true;
    }
    DI void a_ready(const Unit&) const {}
    DI void done(const Unit&) const {}
};

template <class Epi, class Sched, bool ALIGN_EPI = true, bool SP2 = true>
DI void gemm_phase(LAS unsigned char* lds, const Gemm g, const Sched& S, const Epi& E) {
    const int tid = phase_tid(), wid = __builtin_amdgcn_readfirstlane(tid >> 6), lane = tid & 63, wr = wid >> 2, wc = wid & 3, fr = lane & 15, fq = lane >> 4;
    const int K = g.K;
    unsigned voffA[2], voffB[2];
#pragma unroll
    for (int i = 0; i < 2; ++i) { int R, C; stage_rc(tid * 16 + i * 8192, R, C); const int Rb = Epi::PERM ? ((R & ~31) + perm32(R & 31)) : R;
        voffA[i] = (unsigned)(R * K + C) * 2u; voffB[i] = (unsigned)(Rb * K + C) * 2u; }
    const size_t kstep = (size_t)(BK * 2);
    const size_t hstep = (size_t)HALF * K * 2;
    const size_t tstep = 2 * hstep;
    const unsigned ldsw = (unsigned)wid * 1024u;
    const int aoff = lds_byte(wr * 64 + fr, fq * 8), boff = lds_byte(wc * 32 + fr, fq * 8);
#define PG8_SA(b, h) (((b) * 2 + (h)) * HTB)
#define PG8_SB(b, h) ((4 + (b) * 2 + (h)) * HTB)
#define PG8_STAGE(bufoff, gbase, voff) do { _Pragma("unroll") for (int _i = 0; _i < 2; ++_i) \
        __builtin_amdgcn_global_load_lds((const unsigned*)((const char*)(gbase) + (voff)[_i]), (LAS unsigned*)(lds + (bufoff) + ldsw + _i * 8192), 16, 0, 0); } while (0)
#define PG8_LDA(dst, b, h) do { _Pragma("unroll") for (int m = 0; m < 4; ++m) _Pragma("unroll") for (int k = 0; k < 2; ++k) dst[m][k] = *(const LAS bf16x8*)(lds + PG8_SA(b, h) + aoff + m * 2048 + k * 1024); } while (0)
#define PG8_LDB(dst, b, h) do { _Pragma("unroll") for (int n = 0; n < 2; ++n) _Pragma("unroll") for (int k = 0; k < 2; ++k) dst[n][k] = *(const LAS bf16x8*)(lds + PG8_SB(b, h) + boff + n * 2048 + k * 1024); } while (0)
#define PG8_MMA(ai, bj, At, Bt) do { __builtin_amdgcn_s_setprio(1); _Pragma("unroll") for (int m = 0; m < 4; ++m) _Pragma("unroll") for (int n = 0; n < 2; ++n) _Pragma("unroll") for (int k = 0; k < 2; ++k) \
        acc[ai][bj][m][n] = __builtin_amdgcn_mfma_f32_16x16x32_bf16(Bt[n][k], At[m][k], acc[ai][bj][m][n], 0, 0, 0); __builtin_amdgcn_s_setprio(0); } while (0)
#define PG8_WAIT_V(n) asm volatile("s_waitcnt vmcnt(" #n ")" ::: "memory")
#define PG8_WAIT_L(n) asm volatile("s_waitcnt lgkmcnt(" #n ")" ::: "memory")
#define PG8_BAR __builtin_amdgcn_s_barrier()
#define PG8_SCHED __builtin_amdgcn_sched_barrier(0)
    Unit cur, nxt; int ui = 0;
    if (!S.next(0, cur)) return;
    f32x4 acc[2][2][4][2];
#pragma unroll
    for (int a = 0; a < 2; ++a)
#pragma unroll
        for (int b = 0; b < 2; ++b)
#pragma unroll
            for (int m = 0; m < 4; ++m)
#pragma unroll
                for (int n = 0; n < 2; ++n) acc[a][b][m][n] = (f32x4){0.f, 0.f, 0.f, 0.f};
    bf16x8 At[4][2], B0[2][2], B1[2][2];
    const char* cA = (const char*)g.A + (size_t)cur.pm * tstep + (size_t)cur.k0 * 2; const char* cB = (const char*)g.Bt + (size_t)cur.pn * tstep + (size_t)cur.k0 * 2;
    S.a_ready(cur);
    if constexpr (SP2) {
        PG8_STAGE(PG8_SB(0, 0), cB, voffB); PG8_STAGE(PG8_SB(0, 1), cB + hstep, voffB); PG8_STAGE(PG8_SA(0, 0), cA, voffA); PG8_STAGE(PG8_SA(0, 1), cA + hstep, voffA);
        if (wr == 1) PG8_BAR;
        PG8_WAIT_V(2); PG8_BAR;
        PG8_STAGE(PG8_SB(1, 0), cB + kstep, voffB); PG8_STAGE(PG8_SA(1, 0), cA + kstep, voffA); PG8_STAGE(PG8_SB(1, 1), cB + hstep + kstep, voffB);
        PG8_WAIT_V(6); PG8_BAR;
    } else {
        PG8_STAGE(PG8_SB(0, 0), cB, voffB); PG8_STAGE(PG8_SA(0, 0), cA, voffA); PG8_STAGE(PG8_SB(0, 1), cB + hstep, voffB); PG8_STAGE(PG8_SA(0, 1), cA + hstep, voffA);
        if (wr == 1) PG8_BAR;
        PG8_WAIT_V(4); PG8_BAR;
        PG8_STAGE(PG8_SB(1, 0), cB + kstep, voffB); PG8_STAGE(PG8_SA(1, 0), cA + kstep, voffA); PG8_STAGE(PG8_SB(1, 1), cB + hstep + kstep, voffB);
        PG8_WAIT_V(6); PG8_BAR;
    }
    for (;;) {
        const bool has_next = S.next(ui + 1, nxt);
        const char* nA = has_next ? (const char*)g.A + (size_t)nxt.pm * tstep + (size_t)nxt.k0 * 2 : cA; const char* nB = has_next ? (const char*)g.Bt + (size_t)nxt.pn * tstep + (size_t)nxt.k0 * 2 : cB;
        const int nt = cur.nt;
        for (int t = 0; t < nt; t += 2) {
            const bool last = (t == nt - 2);
            const char* a1 = cA + (size_t)(t + 1) * kstep;
            const char* a2 = last ? nA : cA + (size_t)(t + 2) * kstep; const char* b2 = last ? nB : cB + (size_t)(t + 2) * kstep;
            const char* a3 = a2 + kstep; const char* b3 = b2 + kstep;
            if (last && has_next) S.a_ready(nxt);
            if constexpr (SP2) {
            PG8_LDB(B0, 0, 0); PG8_LDB(B1, 0, 1); PG8_SCHED; PG8_LDA(At, 0, 0); PG8_STAGE(PG8_SA(1, 1), a1 + hstep, voffA);
            PG8_WAIT_V(8); PG8_WAIT_L(0); PG8_BAR; PG8_MMA(0, 0, At, B0); PG8_MMA(0, 1, At, B1); PG8_BAR; PG8_SCHED;
            PG8_LDA(At, 0, 1); PG8_STAGE(PG8_SB(0, 0), b2, voffB); PG8_STAGE(PG8_SB(0, 1), b2 + hstep, voffB); PG8_STAGE(PG8_SA(0, 0), a2, voffA);
            PG8_WAIT_V(8); PG8_WAIT_L(0); PG8_BAR; PG8_MMA(1, 0, At, B0); PG8_MMA(1, 1, At, B1); PG8_BAR; PG8_SCHED;
            PG8_LDB(B0, 1, 0); PG8_LDB(B1, 1, 1); PG8_SCHED; PG8_LDA(At, 1, 0); PG8_STAGE(PG8_SA(0, 1), a2 + hstep, voffA);
            PG8_WAIT_V(8); PG8_WAIT_L(0); PG8_BAR; PG8_MMA(0, 0, At, B0); PG8_MMA(0, 1, At, B1); PG8_BAR; PG8_SCHED;
            PG8_LDA(At, 1, 1); PG8_STAGE(PG8_SB(1, 0), b3, voffB); PG8_STAGE(PG8_SB(1, 1), b3 + hstep, voffB); PG8_STAGE(PG8_SA(1, 0), a3, voffA);
            PG8_WAIT_V(8); PG8_WAIT_L(0); PG8_BAR; PG8_MMA(1, 0, At, B0); PG8_MMA(1, 1, At, B1); PG8_BAR; PG8_SCHED;
            } else {
            PG8_LDB(B0, 0, 0); PG8_SCHED; PG8_LDA(At, 0, 0); PG8_STAGE(PG8_SA(1, 1), a1 + hstep, voffA);
            PG8_WAIT_L(8); PG8_BAR; PG8_WAIT_L(0); PG8_MMA(0, 0, At, B0); PG8_BAR; PG8_SCHED;
            PG8_LDB(B1, 0, 1); PG8_STAGE(PG8_SB(0, 0), b2, voffB);
            PG8_BAR; PG8_WAIT_L(0); PG8_MMA(0, 1, At, B1); PG8_BAR;
            PG8_LDA(At, 0, 1); PG8_STAGE(PG8_SA(0, 0), a2, voffA);
            PG8_BAR; PG8_WAIT_L(0); PG8_MMA(1, 0, At, B0); PG8_BAR; PG8_SCHED;
            PG8_STAGE(PG8_SB(0, 1), b2 + hstep, voffB);
            PG8_WAIT_V(6); PG8_BAR; PG8_MMA(1, 1, At, B1); PG8_BAR;
            PG8_LDB(B0, 1, 0); PG8_SCHED; PG8_LDA(At, 1, 0); PG8_STAGE(PG8_SA(0, 1), a2 + hstep, voffA);
            PG8_WAIT_L(8); PG8_BAR; PG8_WAIT_L(0); PG8_MMA(0, 0, At, B0); PG8_BAR; PG8_SCHED;
            PG8_LDB(B1, 1, 1); PG8_STAGE(PG8_SB(1, 0), b3, voffB);
            PG8_BAR; PG8_WAIT_L(0); PG8_MMA(0, 1, At, B1); PG8_BAR;
            PG8_LDA(At, 1, 1); PG8_STAGE(PG8_SA(1, 0), a3, voffA);
            PG8_BAR; PG8_WAIT_L(0); PG8_MMA(1, 0, At, B0); PG8_BAR; PG8_SCHED;
            PG8_STAGE(PG8_SB(1, 1), b3 + hstep, voffB);
            PG8_WAIT_V(6); PG8_BAR; PG8_MMA(1, 1, At, B1); PG8_BAR;
            }
        }
        if constexpr (ALIGN_EPI) { if (wr == 0) PG8_BAR; }
        E(acc, cur, wr, wc, fr, fq); S.done(cur);
        if (!has_next) break;
#pragma unroll
        for (int a = 0; a < 2; ++a)
#pragma unroll
            for (int b = 0; b < 2; ++b)
#pragma unroll
                for (int m = 0; m < 4; ++m)
#pragma unroll
                    for (int n = 0; n < 2; ++n) acc[a][b][m][n] = (f32x4){0.f, 0.f, 0.f, 0.f};
        cur = nxt; cA = nA; cB = nB; ++ui;
        if constexpr (ALIGN_EPI) { if (wr == 1) PG8_BAR; }
    }
    PG8_WAIT_V(0);
    if constexpr (!ALIGN_EPI) { if (wr == 0) PG8_BAR; }
    PG8_BAR;
#undef PG8_SA
#undef PG8_SB
#undef PG8_STAGE
#undef PG8_LDA
#undef PG8_LDB
#undef PG8_MMA
#undef PG8_WAIT_V
#undef PG8_WAIT_L
#undef PG8_BAR
#undef PG8_SCHED
}

struct EpiF32 {
    static constexpr bool PERM = false;
    float* C; int ldc;
    DI void operator()(const f32x4 (&acc)[2][2][4][2], const Unit& u, int wr, int wc, int fr, int fq) const {
        const int row0 = u.pm * BM + wr * 64 + fr, col0 = u.pn * BM + wc * 32 + 4 * fq;
#pragma unroll
        for (int ai = 0; ai < 2; ++ai)
#pragma unroll
            for (int m = 0; m < 4; ++m) { float* rowp = C + (size_t)(row0 + ai * HALF + m * 16) * ldc + col0;
#pragma unroll
                for (int bj = 0; bj < 2; ++bj)
#pragma unroll
                    for (int n = 0; n < 2; ++n) *(f32x4*)(rowp + bj * HALF + n * 16) = acc[ai][bj][m][n]; }
    }
};
struct EpiDown {
    static constexpr bool PERM = true;
    bf16_t* D; float* PART;
    DI void operator()(const f32x4 (&acc)[2][2][4][2], const Unit& u, int wr, int wc, int fr, int fq) const {
        const int rl0 = wr * 64 + fr, col0 = u.pn * BM + wc * 32 + 8 * fq;
        if (u.part < 0) {
            bf16_t* base = D + (size_t)(u.pm * BM + rl0) * DM + col0;
#pragma unroll
            for (int ai = 0; ai < 2; ++ai)
#pragma unroll
                for (int m = 0; m < 4; ++m) {
#pragma unroll
                    for (int bj = 0; bj < 2; ++bj) { const f32x4 v0 = acc[ai][bj][m][0], v1 = acc[ai][bj][m][1];
                        u32x4 w; w.x = pk_bf16(v0[0], v0[1]); w.y = pk_bf16(v0[2], v0[3]); w.z = pk_bf16(v1[0], v1[1]); w.w = pk_bf16(v1[2], v1[3]);
                        *(u32x4*)(base + (ai * HALF + m * 16) * DM + bj * HALF) = w; }
                    asm volatile("" ::: "memory");
                }
        } else {
            float* base = PART + ((size_t)u.part * 256 + rl0) * DM + col0;
#pragma unroll
            for (int ai = 0; ai < 2; ++ai)
#pragma unroll
                for (int m = 0; m < 4; ++m) {
#pragma unroll
                    for (int bj = 0; bj < 2; ++bj) { *(f32x4*)(base + (ai * HALF + m * 16) * DM + bj * HALF) = acc[ai][bj][m][0]; *(f32x4*)(base + (ai * HALF + m * 16) * DM + bj * HALF + 4) = acc[ai][bj][m][1]; }
                    asm volatile("" ::: "memory");
                }
        }
    }
};
struct EpiSwiglu {
    static constexpr bool PERM = true;
    bf16_t* H;
    DI void operator()(const f32x4 (&acc)[2][2][4][2], const Unit& u, int wr, int wc, int fr, int fq) const {
        const int row0 = u.pm * BM + wr * 64 + fr, col0 = u.pn * HALF + wc * 32 + 8 * fq;
#pragma unroll
        for (int ai = 0; ai < 2; ++ai)
#pragma unroll
            for (int m = 0; m < 4; ++m) {
                bf16_t* rowp = H + (size_t)(row0 + ai * HALF + m * 16) * DFF + col0;
                float hv[8];
#pragma unroll
                for (int n = 0; n < 2; ++n)
#pragma unroll
                    for (int j = 0; j < 4; ++j) { const float gt = acc[ai][0][m][n][j], up = acc[ai][1][m][n][j]; hv[n * 4 + j] = gt * sigmoidf_(gt) * up; }
                u32x4 w; w.x = pk_bf16(hv[0], hv[1]); w.y = pk_bf16(hv[2], hv[3]); w.z = pk_bf16(hv[4], hv[5]); w.w = pk_bf16(hv[6], hv[7]);
                *(u32x4*)rowp = w;
            }
    }
};
struct EpiInProj {
    static constexpr bool PERM = true;
    bf16_t *Q, *KP, *KS, *VtP, *VtS, *GG; float *LX, *out;
    DI void operator()(const f32x4 (&acc)[2][2][4][2], const Unit& u, int wr, int wc, int fr, int fq) const {
        const int kind = u.pn >> 1;
        const int cbase = (u.pn & 1) * 256 + wc * 32 + 8 * fq;
        const bool samp = (u.pm == MP / 256);
#pragma unroll
        for (int ai = 0; ai < 2; ++ai)
#pragma unroll
            for (int m = 0; m < 4; ++m) {
                const int row = u.pm * BM + ai * HALF + wr * 64 + m * 16 + fr;
                const int rs = row - MP, sb = rs >> 5, st = rs & 31;
#pragma unroll
                for (int bj = 0; bj < 2; ++bj) {
                    const int col = cbase + bj * HALF;
                    const f32x4 v0 = acc[ai][bj][m][0], v1 = acc[ai][bj][m][1];
                    if (kind == 0) {
                        const float c1 = 0.125f * LOG2E;
                        u32x4 w; w.x = pk_bf16(v0[0] * c1, v0[1] * c1); w.y = pk_bf16(v0[2] * c1, v0[3] * c1); w.z = pk_bf16(v1[0] * c1, v1[1] * c1); w.w = pk_bf16(v1[2] * c1, v1[3] * c1);
                        *(u32x4*)(Q + (size_t)row * 512 + col) = w;
                    } else if (kind == 1) {
                        u32x4 w; w.x = pk_bf16(v0[0], v0[1]); w.y = pk_bf16(v0[2], v0[3]); w.z = pk_bf16(v1[0], v1[1]); w.w = pk_bf16(v1[2], v1[3]);
                        const int hd = col >> 7, cl = col & 127;
                        if (!samp) { float* o = out + OUT_KP + (size_t)row * 512 + col; __builtin_nontemporal_store(v0, (f32x4*)o); __builtin_nontemporal_store(v1, (f32x4*)(o + 4));
                            *(u32x4*)(KP + ((size_t)((row >> 13) * 4 + hd) * TP + (row & (TP - 1))) * 128 + cl) = w; }
                        else { float* o = out + OUT_KS + (size_t)rs * 512 + col; __builtin_nontemporal_store(v0, (f32x4*)o); __builtin_nontemporal_store(v1, (f32x4*)(o + 4));
                            *(u32x4*)(KS + ((size_t)(sb * 4 + hd) * TSP + PAST + st) * 128 + cl) = w; }
                    } else if (kind == 2) {
                        bf16_t* vt;
                        const int hd = col >> 7, dv = col & 127;
                        if (!samp) { float* o = out + OUT_VP + (size_t)row * 512 + col; __builtin_nontemporal_store(v0, (f32x4*)o); __builtin_nontemporal_store(v1, (f32x4*)(o + 4)); const int t = row & (TP - 1);
                            vt = VtP + (((size_t)((row >> 13) * 4 + hd) * (TP / 64) + (t >> 6)) * 128 + dv) * 64 + vpos(t & 63); }
                        else { float* o = out + OUT_VS + (size_t)rs * 512 + col; __builtin_nontemporal_store(v0, (f32x4*)o); __builtin_nontemporal_store(v1, (f32x4*)(o + 4)); const int t = PAST + st;
                            vt = VtS + (((size_t)(sb * 4 + hd) * (TSP / 64) + (t >> 6)) * 128 + dv) * 64 + vpos(t & 63); }
                        const unsigned w0 = pk_bf16(v0[0], v0[1]), w1 = pk_bf16(v0[2], v0[3]), w2 = pk_bf16(v1[0], v1[1]), w3 = pk_bf16(v1[2], v1[3]);
                        vt[0] = (bf16_t)(w0 & 0xffffu); vt[64] = (bf16_t)(w0 >> 16); vt[128] = (bf16_t)(w1 & 0xffffu); vt[192] = (bf16_t)(w1 >> 16);
                        vt[256] = (bf16_t)(w2 & 0xffffu); vt[320] = (bf16_t)(w2 >> 16); vt[384] = (bf16_t)(w3 & 0xffffu); vt[448] = (bf16_t)(w3 >> 16);
                    } else if (kind == 3) {
                        float* o = LX + (size_t)row * 512 + col; *(f32x4*)o = v0; *(f32x4*)(o + 4) = v1;
                    } else {
                        u32x4 w; w.x = pk_bf16(gelu_tanh(v0[0]), gelu_tanh(v0[1])); w.y = pk_bf16(gelu_tanh(v0[2]), gelu_tanh(v0[3])); w.z = pk_bf16(gelu_tanh(v1[0]), gelu_tanh(v1[1])); w.w = pk_bf16(gelu_tanh(v1[2]), gelu_tanh(v1[3]));
                        *(u32x4*)(GG + (size_t)row * 512 + col) = w;
                    }
                }
            }
    }
};
}

struct TJob { const float* src; bf16_t* dst; int K, N, ds, mode; };
DI void transpose_tile_wave(LAS float* tile, int lane, const TJob& j, int t) {
    const int ntn = j.N >> 6, k0 = (t / ntn) << 6, n0 = (t % ntn) << 6;
    const float* s = j.src + (size_t)(k0 + (lane >> 4)) * j.N + n0 + (lane & 15) * 4;
    f32x4 v[16];
#pragma unroll
    for (int i = 0; i < 16; ++i) v[i] = *(const f32x4*)(s + (size_t)(i * 4) * j.N);
    LAS float* tp = tile + (lane >> 4) * 65 + (lane & 15) * 4;
#pragma unroll
    for (int i = 0; i < 16; ++i) { tp[i * 4 * 65 + 0] = v[i][0]; tp[i * 4 * 65 + 1] = v[i][1]; tp[i * 4 * 65 + 2] = v[i][2]; tp[i * 4 * 65 + 3] = v[i][3]; }
    asm volatile("s_waitcnt lgkmcnt(0)" ::: "memory");
    const int ks = (lane & 7) * 8;
    const LAS float* rp = tile + ks * 65 + (lane >> 3);
#pragma unroll
    for (int q = 0; q < 8; ++q) {
        float w[8];
#pragma unroll
        for (int e = 0; e < 8; ++e) w[e] = rp[e * 65 + q * 8];
        const int nn = n0 + q * 8 + (lane >> 3);
        u32x4 o; o.x = pk_bf16(w[0], w[1]); o.y = pk_bf16(w[2], w[3]); o.z = pk_bf16(w[4], w[5]); o.w = pk_bf16(w[6], w[7]);
        if (j.mode != 3) { const int R = (j.mode == 0) ? nn : (((nn >> 7) << 8) + (nn & 127) + (j.mode == 2 ? 128 : 0));
            *(u32x4*)(j.dst + (size_t)R * j.ds + k0 + ks) = o; }
        else { bf16_t* d = j.dst + (((size_t)(nn >> 7) * (TSP / 64) + (k0 >> 6)) * 128 + (nn & 127)) * 64 + (ks & 48) + ((ks & 8) >> 1);
               *(u32x2*)d = (u32x2){o.x, o.y}; *(u32x2*)(d + 8) = (u32x2){o.z, o.w}; }
    }
    asm volatile("s_waitcnt lgkmcnt(0)" ::: "memory");
}
constexpr int NWT_FFN1UP = 1408, NWT_ALL = 5136;
DI void weight_tile(const Params& p, LAS float* tile, int lane, int idx) {
    unsigned char* ws = p.ws; TJob j; int t;
    if (idx < 704)       { j = TJob{p.in[I_F1G], (bf16_t*)(ws + WS_WGU1), DM, DFF, DM, 1}; t = idx; }
    else if (idx < 1408) { j = TJob{p.in[I_F1U], (bf16_t*)(ws + WS_WGU1), DM, DFF, DM, 2}; t = idx - 704; }
    else if (idx < 2112) { j = TJob{p.in[I_F1D], (bf16_t*)(ws + WS_WD1), DFF, DM, DFF, 0}; t = idx - 1408; }
    else if (idx < 2752) { j = TJob{p.in[I_WIN], (bf16_t*)(ws + WS_WIN), DM, DIN, DM, 0}; t = idx - 2112; }
    else if (idx < 3008) { j = TJob{p.in[I_WOUT], (bf16_t*)(ws + WS_WOUT), DM, DM, DM, 0}; t = idx - 2752; }
    else if (idx < 3712) { j = TJob{p.in[I_F2G], (bf16_t*)(ws + WS_WGU2), DM, DFF, DM, 1}; t = idx - 3008; }
    else if (idx < 4416) { j = TJob{p.in[I_F2U], (bf16_t*)(ws + WS_WGU2), DM, DFF, DM, 2}; t = idx - 3712; }
    else if (idx < 5120) { j = TJob{p.in[I_F2D], (bf16_t*)(ws + WS_WD2), DFF, DM, DFF, 0}; t = idx - 4416; }
    else if (idx < 5128) { j = TJob{p.in[I_WR], (bf16_t*)(ws + WS_WRT), 512, 64, 512, 0}; t = idx - 5120; }
    else                 { j = TJob{p.in[I_WI], (bf16_t*)(ws + WS_WIT), 512, 64, 512, 0}; t = idx - 5128; }
    transpose_tile_wave(tile, lane, j, t);
}
DI void convert_weights_p0(const Params& p, LAS unsigned char* lds) {
    const int tid = phase_tid(), lane = tid & 63, wv = __builtin_amdgcn_readfirstlane(tid >> 6), gw = blockIdx.x * 8 + wv, nw = gridDim.x * 8;
    LAS float* tile = (LAS float*)(lds + wv * (64 * 65 * 4));
    for (int idx = gw; idx < NWT_FFN1UP; idx += nw) weight_tile(p, tile, lane, idx);
}
constexpr int NCU_V = NBS * 512, NCU_ALL = NCU_V + NBS * (PAST / 16);
DI void cache_unit(const Params& p, LAS float* tile, int lane, int idx) {
    if (idx < NCU_V) {
        const int b = idx >> 9;
        const TJob j{p.in[I_CV] + (size_t)b * PAST * 512, (bf16_t*)(p.ws + WS_VTS) + (size_t)b * 512 * TSP, PAST, 512, TSP, 3};
        transpose_tile_wave(tile, lane, j, idx & 511);
    } else {
        const int u = idx - NCU_V, b = u >> 8, t0 = (u & 255) * 16;
        const float* s = p.in[I_CK] + ((size_t)b * PAST + t0) * 512 + lane * 8;
        bf16_t* d = (bf16_t*)(p.ws + WS_KS) + ((size_t)(b * 4 + (lane >> 4)) * TSP + t0) * 128 + (lane & 15) * 8;
        f32x4 v[32];
#pragma unroll
        for (int r = 0; r < 16; ++r) { v[2 * r] = *(const f32x4*)(s + (size_t)r * 512); v[2 * r + 1] = *(const f32x4*)(s + (size_t)r * 512 + 4); }
#pragma unroll
        for (int r = 0; r < 16; ++r) { u32x4 w; w.x = pk_bf16(v[2 * r][0], v[2 * r][1]); w.y = pk_bf16(v[2 * r][2], v[2 * r][3]); w.z = pk_bf16(v[2 * r + 1][0], v[2 * r + 1][1]); w.w = pk_bf16(v[2 * r + 1][2], v[2 * r + 1][3]);
            *(u32x4*)(d + (size_t)r * 128) = w; }
    }
}
template <int KIND> DI void filler_loop(const Params& p, LAS unsigned char* lds, unsigned* cnt, int first, int total) {
    const int tid = phase_tid(), lane = tid & 63, wv = __builtin_amdgcn_readfirstlane(tid >> 6);
    LAS float* tile = (LAS float*)(lds + wv * (64 * 65 * 4));
    LAS int* slot = (LAS int*)(lds + LDS_CTL);
    const int nchunks = (total - first + 7) >> 3;
    for (;;) {
        if (tid == 0) *slot = (int)atomicAdd(cnt, 1u);
        __syncthreads();
        const int c = *slot;
        __syncthreads();
        if (c >= nchunks) break;
        const int idx = first + c * 8 + wv;
        if (idx < total) { if (KIND == 0) weight_tile(p, tile, lane, idx); else cache_unit(p, tile, lane, idx); }
    }
}

DI const float* xrow(const Params& p, int row) { return row < MP ? p.in[I_XP] + (size_t)row * DM : p.in[I_XS] + (size_t)(row - MP) * DM; }
DI void store_xn(bf16_t* XN, int row, int lane, const f32x4 (&v)[4], float r, const f32x4 (&g)[4]) {
#pragma unroll
    for (int i = 0; i < 4; ++i) { u32x2 w; w.x = pk_bf16(v[i][0] * r * g[i][0], v[i][1] * r * g[i][1]); w.y = pk_bf16(v[i][2] * r * g[i][2], v[i][3] * r * g[i][3]);
        *(u32x2*)(XN + (size_t)row * DM + i * 256 + lane * 4) = w; }
}
DI float sumsq(const f32x4 (&v)[4]) { float s = 0.f;
#pragma unroll
    for (int i = 0; i < 4; ++i) s += v[i][0] * v[i][0] + v[i][1] * v[i][1] + v[i][2] * v[i][2] + v[i][3] * v[i][3];
    return wave_sum(s); }
DI void load_d(const bf16_t* Dh, const float* PART, int nparts, int row, int lane, f32x4 (&d)[4]) {
    if (row < MP) {
#pragma unroll
        for (int i = 0; i < 4; ++i) { const u32x2 w = *(const u32x2*)(Dh + (size_t)row * DM + i * 256 + lane * 4);
            d[i] = (f32x4){__uint_as_float(w.x << 16), __uint_as_float(w.x & 0xffff0000u), __uint_as_float(w.y << 16), __uint_as_float(w.y & 0xffff0000u)}; }
    } else {
#pragma unroll
        for (int i = 0; i < 4; ++i) d[i] = (f32x4){0.f, 0.f, 0.f, 0.f};
#pragma nounroll
        for (int k = 0; k < nparts; ++k)
#pragma unroll
            for (int i = 0; i < 4; ++i) d[i] += *(const f32x4*)(PART + ((size_t)k * 256 + (row - MP)) * DM + i * 256 + lane * 4);
    }
}
template <int MODE> DI void row_pair(const Params& p, int r0, int r1, int lane, const bf16_t* Dh, const float* PART, int nparts, float* Y, bf16_t* XN, const f32x4 (&gp)[4], const f32x4 (&gq)[4], float cs, bool from_x) {
    f32x4 x0[4], x1[4], d0[4], d1[4];
    const float* xp0 = (MODE == 0 || from_x) ? xrow(p, r0) : Y + (size_t)r0 * DM;
    const float* xp1 = (MODE == 0 || from_x) ? xrow(p, r1) : Y + (size_t)r1 * DM;
#pragma unroll
    for (int i = 0; i < 4; ++i) { x0[i] = *(const f32x4*)(xp0 + i * 256 + lane * 4); x1[i] = *(const f32x4*)(xp1 + i * 256 + lane * 4); }
    if (MODE != 0) {
        load_d(Dh, PART, nparts, r0, lane, d0); load_d(Dh, PART, nparts, r1, lane, d1);
        const float rd0 = cs * rsqrtf(sumsq(d0) * (1.0f / DM) + RMS_EPS), rd1 = cs * rsqrtf(sumsq(d1) * (1.0f / DM) + RMS_EPS);
#pragma unroll
        for (int i = 0; i < 4; ++i) { x0[i] = x0[i] + d0[i] * rd0 * gp[i]; x1[i] = x1[i] + d1[i] * rd1 * gp[i];
            *(f32x4*)(Y + (size_t)r0 * DM + i * 256 + lane * 4) = x0[i]; *(f32x4*)(Y + (size_t)r1 * DM + i * 256 + lane * 4) = x1[i]; }
    }
    if (MODE != 2) {
        const float q0 = rsqrtf(sumsq(x0) * (1.0f / DM) + RMS_EPS), q1 = rsqrtf(sumsq(x1) * (1.0f / DM) + RMS_EPS);
        store_xn(XN, r0, lane, x0, q0, gq); store_xn(XN, r1, lane, x1, q1, gq);
    }
}
template <int MODE> DI void row_phase(const Params& p, const bf16_t* Dh, const float* PART, int nparts, float* Y, bf16_t* XN, const float* gpost, const float* gpre, float cs, bool from_x) {
    const int tid_ = phase_tid(), lane = tid_ & 63, wv = __builtin_amdgcn_readfirstlane(tid_ >> 6), gw = blockIdx.x * 8 + wv, nw = gridDim.x * 8;
    f32x4 gp[4], gq[4];
#pragma unroll
    for (int i = 0; i < 4; ++i) { gp[i] = (MODE != 0) ? *(const f32x4*)(gpost + i * 256 + lane * 4) : (f32x4){0.f, 0.f, 0.f, 0.f}; gq[i] = (MODE != 2) ? *(const f32x4*)(gpre + i * 256 + lane * 4) : (f32x4){0.f, 0.f, 0.f, 0.f}; }
#pragma nounroll
    for (int pr = gw; pr < MP / 2; pr += nw) row_pair<MODE>(p, 2 * pr, 2 * pr + 1, lane, Dh, PART, nparts, Y, XN, gp, gq, cs, from_x);
    if (wv == 0) {
#pragma nounroll
        for (int r = MP + blockIdx.x; r < MT; r += gridDim.x) row_pair<MODE>(p, r, r, lane, Dh, PART, nparts, Y, XN, gp, gq, cs, from_x);
    }
}

constexpr int LRS = 68;
DI int crow16(int reg, int hh) { return (reg & 3) + 8 * (reg >> 2) + 4 * hh; }
struct LruConst { float cw0, cw1, cw2, cw3, cb, sp8[2], brv[2], biv[2]; bf16x8 fwr[2][4], fwi[2][4]; };
DI void lru_load_const(const Params& p, LruConst& k) {
    const int tid = phase_tid(), w = __builtin_amdgcn_readfirstlane(tid >> 6), lane = tid & 63, cc = lane & 31, hh = lane >> 5, ch = w * 64 + lane;
    k.cw0 = p.in[I_CW][ch]; k.cw1 = p.in[I_CW][512 + ch]; k.cw2 = p.in[I_CW][1024 + ch]; k.cw3 = p.in[I_CW][1536 + ch]; k.cb = p.in[I_CB][ch];
#pragma unroll
    for (int q = 0; q < 2; ++q) { const int ce = w * 64 + q * 32 + cc; k.sp8[q] = 8.0f * log1pf(__expf(-p.in[I_LAM][ce])); k.brv[q] = p.in[I_BR][ce]; k.biv[q] = p.in[I_BI][ce]; }
    const bf16_t* WRT = (const bf16_t*)(p.ws + WS_WRT); const bf16_t* WIT = (const bf16_t*)(p.ws + WS_WIT);
    const size_t wo = (size_t)cc * 512 + w * 64 + hh * 8;
#pragma unroll
    for (int q = 0; q < 2; ++q)
#pragma unroll
        for (int ks = 0; ks < 4; ++ks) { k.fwr[q][ks] = *(const bf16x8*)(WRT + wo + (size_t)q * 32 * 512 + ks * 16); k.fwi[q][ks] = *(const bf16x8*)(WIT + wo + (size_t)q * 32 * 512 + ks * 16); }
}
DI void lru_local_item(const Params& p, LAS unsigned char* lds, int item, const LruConst& k) {
    const int tid = phase_tid(), w = __builtin_amdgcn_readfirstlane(tid >> 6), lane = tid & 63, cc = lane & 31, hh = lane >> 5;
    int s, c, row0, nhalf; const bool samp = item >= NBP * 128;
    if (!samp) { s = item >> 7; c = item & 127; row0 = s * TP + c * 64; nhalf = 2; } else { s = NBP + (item - NBP * 128); c = 0; row0 = MP + (s - NBP) * TSQ; nhalf = 1; }
    const float* LX = (const float*)(p.ws + WS_LX);
    bf16_t* PP = (bf16_t*)(p.ws + WS_PP); bf16_t* HL = (bf16_t*)(p.ws + WS_HL);
    LAS float* xs = (LAS float*)(lds + w * (2 * 32 * LRS * 4)); LAS float* as = xs + 32 * LRS;
    const int ch = w * 64 + lane;
    const float cw0 = k.cw0, cw1 = k.cw1, cw2 = k.cw2, cw3 = k.cw3, cb = k.cb;
    float xm3, xm2, xm1;
    if (samp) { const float* sc = p.in[I_SC] + (size_t)(s - NBP) * 3 * 512 + ch; xm3 = sc[0]; xm2 = sc[512]; xm1 = sc[1024]; }
    else if (c == 0) { xm3 = 0.f; xm2 = 0.f; xm1 = 0.f; }
    else { const float* lp = LX + (size_t)(row0 - 3) * 512 + ch; xm3 = lp[0]; xm2 = lp[512]; xm1 = lp[1024]; }
    float Pc = 1.0f, hc = 0.0f;
    LAS float* xe = xs + 4 * hh * LRS + cc;
    LAS float* ae = as + 4 * hh * LRS + cc;
    float xin[2][32];
#pragma unroll
    for (int hf = 0; hf < 2; ++hf)
#pragma unroll
        for (int t = 0; t < 32; ++t) xin[hf][t] = (hf < nhalf) ? LX[(size_t)(row0 + hf * 32 + t) * 512 + ch] : 0.f;
#pragma unroll
    for (int half = 0; half < 2; ++half) {
        if (half >= nhalf) break;
        const int rbase = row0 + half * 32;
#pragma unroll
        for (int t = 0; t < 32; ++t) { const float xv = xin[half][t]; const float y = cb + cw0 * xm3 + cw1 * xm2 + cw2 * xm1 + cw3 * xv; xs[t * LRS + lane] = y; xm3 = xm2; xm2 = xm1; xm1 = xv; }
        asm volatile("s_waitcnt lgkmcnt(0)" ::: "memory");
        bf16x8 af[4];
#pragma unroll
        for (int ks = 0; ks < 4; ++ks) {
            const f32x4 lo = *(const LAS f32x4*)(xs + cc * LRS + ks * 16 + hh * 8), hi = *(const LAS f32x4*)(xs + cc * LRS + ks * 16 + hh * 8 + 4);
            u32x4 pa; pa.x = pk_bf16(lo[0], lo[1]); pa.y = pk_bf16(lo[2], lo[3]); pa.z = pk_bf16(hi[0], hi[1]); pa.w = pk_bf16(hi[2], hi[3]);
            af[ks] = __builtin_bit_cast(bf16x8, pa);
        }
#pragma unroll
        for (int q = 0; q < 2; ++q) {
            const float sp8 = k.sp8[q], brv = k.brv[q];
            f32x16 acc;
#pragma unroll
            for (int e = 0; e < 16; ++e) acc[e] = 0.f;
#pragma unroll
            for (int ks = 0; ks < 4; ++ks) acc = __builtin_amdgcn_mfma_f32_32x32x16_bf16(af[ks], k.fwr[q][ks], acc, 0, 0, 0);
#pragma unroll
            for (int e = 0; e < 16; ++e) { const float rg = sigmoidf_(acc[e] + brv); ae[((e & 3) + 8 * (e >> 2)) * LRS + q * 32] = __expf(-rg * sp8); }
            asm volatile("" ::: "memory");
        }
#pragma unroll
        for (int q = 0; q < 2; ++q) {
            const float biv = k.biv[q];
            f32x16 acc;
#pragma unroll
            for (int e = 0; e < 16; ++e) acc[e] = 0.f;
#pragma unroll
            for (int ks = 0; ks < 4; ++ks) acc = __builtin_amdgcn_mfma_f32_32x32x16_bf16(af[ks], k.fwi[q][ks], acc, 0, 0, 0);
#pragma unroll
            for (int e = 0; e < 16; ++e) { const int ix = ((e & 3) + 8 * (e >> 2)) * LRS + q * 32; const float ig = sigmoidf_(acc[e] + biv), a = ae[ix], xc = xe[ix];
                xe[ix] = sqrtf(fmaxf(1.0f - a * a, 0.0f)) * ig * xc; }
            asm volatile("" ::: "memory");
        }
        asm volatile("s_waitcnt lgkmcnt(0)" ::: "memory");
#pragma unroll 8
        for (int t = 0; t < 32; ++t) { const float a = as[t * LRS + lane], bx = xs[t * LRS + lane]; Pc *= a; hc = a * hc + bx;
            const size_t o = (size_t)(rbase + t) * 512 + ch; PP[o] = (bf16_t)(pk_bf16(Pc, 0.f) & 0xffffu); HL[o] = (bf16_t)(pk_bf16(hc, 0.f) & 0xffffu); }
        asm volatile("s_waitcnt lgkmcnt(0)" ::: "memory");
    }
    float* AP = (float*)(p.ws + WS_AP); float* HE = (float*)(p.ws + WS_HE);
    AP[(size_t)(s * 128 + c) * 512 + ch] = Pc; HE[(size_t)(s * 128 + c) * 512 + ch] = hc;
}

DI void lru_carry_scan(const Params& p, int s) {
    const int ch = phase_tid();
    const float* AP = (const float*)(p.ws + WS_AP) + (size_t)s * 128 * 512 + ch; const float* HE = (const float*)(p.ws + WS_HE) + (size_t)s * 128 * 512 + ch;
    float* CAR = (float*)(p.ws + WS_CAR) + (size_t)s * 128 * 512 + ch;
    float carry = 0.0f;
    for (int c0 = 0; c0 < 128; c0 += 16) {
        float a[16], h[16];
#pragma unroll
        for (int j = 0; j < 16; ++j) { a[j] = AP[(size_t)(c0 + j) * 512]; h[j] = HE[(size_t)(c0 + j) * 512]; }
#pragma unroll
        for (int j = 0; j < 16; ++j) { CAR[(size_t)(c0 + j) * 512] = carry; carry = a[j] * carry + h[j]; }
    }
    p.out[OUT_LHP + (size_t)s * 512 + ch] = carry;
    __threadfence();
    __syncthreads();
    if (threadIdx.x == 0) __hip_atomic_fetch_add((unsigned*)(p.ws + WS_CNT) + 1, 1u, __ATOMIC_RELEASE, __HIP_MEMORY_SCOPE_AGENT);
}
DI void lru_final_item(const Params& p, int item) {
    const int ch = phase_tid();
    int s, c, row0, ntok; const bool samp = item >= NBP * 128;
    if (!samp) { s = item >> 7; c = item & 127; row0 = s * TP + c * 64; ntok = 64; } else { s = NBP + (item - NBP * 128); c = 0; row0 = MP + (s - NBP) * TSQ; ntok = 32; }
    const bf16_t* PP = (const bf16_t*)(p.ws + WS_PP); const bf16_t* HL = (const bf16_t*)(p.ws + WS_HL); const bf16_t* GG = (const bf16_t*)(p.ws + WS_GG);
    bf16_t* MIX = (bf16_t*)(p.ws + WS_C);
    float carry;
    if (samp) carry = p.in[I_SH][(size_t)(s - NBP) * 512 + ch];
    else {
        if (threadIdx.x == 0) { const unsigned* fl = (const unsigned*)(p.ws + WS_CNT) + 1;
            while (__hip_atomic_load(fl, __ATOMIC_RELAXED, __HIP_MEMORY_SCOPE_AGENT) < (unsigned)NBP) __builtin_amdgcn_s_sleep(8);
            __builtin_amdgcn_fence(__ATOMIC_ACQUIRE, "agent"); }
        __syncthreads();
        carry = __hip_atomic_load((const float*)(p.ws + WS_CAR) + (size_t)(s * 128 + c) * 512 + ch, __ATOMIC_RELAXED, __HIP_MEMORY_SCOPE_AGENT);
    }
#pragma unroll 32
    for (int t = 0; t < ntok; ++t) { const size_t o = (size_t)(row0 + t) * 512 + ch; const float hv = bf2f(HL[o]) + bf2f(PP[o]) * carry;
        MIX[(size_t)(row0 + t) * DM + 512 + ch] = (bf16_t)(pk_bf16(hv * bf2f(GG[o]), 0.f) & 0xffffu); }
    if (samp || c == 127) {
        const float* LX = (const float*)(p.ws + WS_LX); const int rl = row0 + ntok - 3;
        if (!samp) {
#pragma unroll
            for (int j = 0; j < 3; ++j) p.out[OUT_CVP + (size_t)(s * 3 + j) * 512 + ch] = LX[(size_t)(rl + j) * 512 + ch]; }
        else { const int b = s - NBP; const size_t o = (size_t)(s * 128) * 512 + ch;
            p.out[OUT_LHS + (size_t)b * 512 + ch] = ((const float*)(p.ws + WS_HE))[o] + ((const float*)(p.ws + WS_AP))[o] * carry;
#pragma unroll
            for (int j = 0; j < 3; ++j) p.out[OUT_CVS + (size_t)(b * 3 + j) * 512 + ch] = LX[(size_t)(rl + j) * 512 + ch]; }
    }
}

DI void knorm_items(const Params& p) {
    if (blockIdx.x < NBS && gridDim.x > 2 * NBS) return;
    const int skip = (gridDim.x > 2 * NBS) ? NBS : 0;
    const int tid_ = phase_tid(), lane = tid_ & 63, gw = (blockIdx.x - skip) * 8 + (tid_ >> 6), nw = (gridDim.x - skip) * 8;
    const int NP = NBP * 4 * 128, NS = NBS * 4 * (TSP / 64);
    for (int it = gw; it < NP + NS; it += nw) {
        const bf16_t* kt; float* dst; bool valid = true;
        if (it < NP) { const int bh = it >> 7, t = it & 127; kt = (const bf16_t*)(p.ws + WS_KP) + ((size_t)bh * TP + t * 64) * 128; dst = (float*)(p.ws + WS_KNP) + (size_t)bh * 256 + t; }
        else { const int j = it - NP, bh = j / (TSP / 64), t = j % (TSP / 64); kt = (const bf16_t*)(p.ws + WS_KS) + ((size_t)bh * TSP + t * 64) * 128; dst = (float*)(p.ws + WS_KNS) + (size_t)bh * 256 + t;
               valid = (t * 64 + lane) < (PAST + TSQ); }
        float n0 = 0.f, n1 = 0.f;
#pragma unroll
        for (int i = 0; i < 16; ++i) { const u32x4 w = *(const u32x4*)(kt + (size_t)lane * 128 + i * 8); float s = 0.f;
#pragma unroll
            for (int j = 0; j < 4; ++j) { const float lo = __uint_as_float(w[j] << 16), hi = __uint_as_float(w[j] & 0xffff0000u); s += lo * lo + hi * hi; }
            if (i < 8) n0 += s; else n1 += s; }
        if (!valid) { n0 = 0.f; n1 = 0.f; }
#pragma unroll
        for (int o = 32; o >= 1; o >>= 1) { n0 = fmaxf(n0, __shfl_xor(n0, o)); n1 = fmaxf(n1, __shfl_xor(n1, o)); }
        if (lane == 0) { dst[0] = n0; dst[128] = n1; }
    }
}

constexpr int ATT_KROW = 272, ATT_VROW = 144, ATT_VOFF = 64 * ATT_KROW, ATT_BUF = ATT_VOFF + 128 * ATT_VROW;
constexpr int ATT_PMT = 2 * ATT_BUF;
constexpr int ATT_PUB = ATT_PMT + 1024;
constexpr float ATT_SKIP = 40.0f;
DI void att_compute(const LAS unsigned char* Kl, int t, int nkb, int qpos0, int cq, int hh, int c, float sl2, const bf16x8 (&qf)[4], f32x16 (&O)[4], float& mrun, float& lrun) {
    const int kb_lim = nkb - 2 * t;
    if (kb_lim <= 0) return;
    const LAS unsigned char* kp = Kl + cq * ATT_KROW + (c * 64 + hh * 8) * 2;
    const LAS unsigned char* vp = Kl + ATT_VOFF + cq * ATT_VROW + hh * 16;
    bf16x8 ka[8];
#pragma unroll
    for (int ks = 0; ks < 4; ++ks) { ka[2 * ks] = *(const LAS bf16x8*)(kp + ks * 32); ka[2 * ks + 1] = *(const LAS bf16x8*)(kp + 32 * ATT_KROW + ks * 32); }
    __builtin_amdgcn_sched_barrier(0);
    f32x16 S0, S1;
#pragma unroll
    for (int e = 0; e < 16; ++e) { S0[e] = 0.f; S1[e] = 0.f; }
#pragma unroll
    for (int ks = 0; ks < 4; ++ks) {
        S0 = __builtin_amdgcn_mfma_f32_32x32x16_bf16(ka[2 * ks], qf[ks], S0, 0, 0, 0);
        S1 = __builtin_amdgcn_mfma_f32_32x32x16_bf16(ka[2 * ks + 1], qf[ks], S1, 0, 0, 0);
    }
    __builtin_amdgcn_sched_barrier(0);
    bf16x8 va[8];
#pragma unroll
    for (int g = 0; g < 2; ++g)
#pragma unroll
        for (int d = 0; d < 4; ++d) va[g * 4 + d] = *(const LAS bf16x8*)(vp + d * 32 * ATT_VROW + g * 32);
    __builtin_amdgcn_sched_barrier(0);
    float rel0 = (float)(qpos0 + cq - (t * 64 + 4 * hh));
    asm volatile("" : "+v"(rel0));
    const float rel1 = rel0 - 32.0f;
    const bool two = kb_lim > 1;
    float mt = -1e30f;
#pragma unroll
    for (int e = 0; e < 16; ++e) { const float off = (float)((e & 3) + 8 * (e >> 2));
        S0[e] = S0[e] - sl2 * fabsf(rel0 - off);
        S1[e] = two ? (S1[e] - sl2 * fabsf(rel1 - off)) : -1e30f;
        mt = fmaxf(mt, fmaxf(S0[e], S1[e])); }
    mt = fmaxf(mt, __shfl_xor(mt, 32));
    if (__any(mt > mrun)) {
        const float mnew = fmaxf(mrun, mt), alpha = __builtin_amdgcn_exp2f(mrun - mnew);
        mrun = mnew; lrun *= alpha;
#pragma unroll
        for (int d = 0; d < 4; ++d)
#pragma unroll
            for (int e = 0; e < 16; ++e) O[d][e] *= alpha;
    }
    float ps = 0.f;
#pragma unroll
    for (int e = 0; e < 16; ++e) { S0[e] = __builtin_amdgcn_exp2f(S0[e] - mrun); S1[e] = __builtin_amdgcn_exp2f(S1[e] - mrun); ps += S0[e] + S1[e]; }
    lrun += ps;
    u32x4 pf[4];
#pragma unroll
    for (int s = 0; s < 2; ++s) {
        pf[s].x = pk_bf16(S0[8 * s + 0], S0[8 * s + 1]); pf[s].y = pk_bf16(S0[8 * s + 2], S0[8 * s + 3]); pf[s].z = pk_bf16(S0[8 * s + 4], S0[8 * s + 5]); pf[s].w = pk_bf16(S0[8 * s + 6], S0[8 * s + 7]);
        pf[2 + s].x = pk_bf16(S1[8 * s + 0], S1[8 * s + 1]); pf[2 + s].y = pk_bf16(S1[8 * s + 2], S1[8 * s + 3]); pf[2 + s].z = pk_bf16(S1[8 * s + 4], S1[8 * s + 5]); pf[2 + s].w = pk_bf16(S1[8 * s + 6], S1[8 * s + 7]);
    }
    __builtin_amdgcn_sched_barrier(0);
    bf16x8 vb[8];
#pragma unroll
    for (int g = 0; g < 2; ++g)
#pragma unroll
        for (int d = 0; d < 4; ++d) vb[g * 4 + d] = *(const LAS bf16x8*)(vp + d * 32 * ATT_VROW + (2 + g) * 32);
    __builtin_amdgcn_sched_barrier(0);
#pragma unroll
    for (int g = 0; g < 2; ++g)
#pragma unroll
        for (int d = 0; d < 4; ++d) O[d] = __builtin_amdgcn_mfma_f32_32x32x16_bf16(va[g * 4 + d], __builtin_bit_cast(bf16x8, pf[g]), O[d], 0, 0, 0);
    __builtin_amdgcn_sched_barrier(0);
#pragma unroll
    for (int g = 0; g < 2; ++g)
#pragma unroll
        for (int d = 0; d < 4; ++d) O[d] = __builtin_amdgcn_mfma_f32_32x32x16_bf16(vb[g * 4 + d], __builtin_bit_cast(bf16x8, pf[2 + g]), O[d], 0, 0, 0);
    __builtin_amdgcn_sched_barrier(0);
}
DI void attn_item(const Params& p, LAS unsigned char* lds, int kind, int b, int h, int qb, float lam, unsigned* qcnt, LAS int* slot) {
    const int tid = phase_tid(), wave = __builtin_amdgcn_readfirstlane(tid >> 6), lane = tid & 63, c = wave >> 2, rg = wave & 3, cq = lane & 31, hh = lane >> 5;
    const bf16_t* Qg = (const bf16_t*)(p.ws + WS_Q);
    const bf16_t *Kb, *Vb; const float* KN; int ntiles, nkb, rowbase, qpos0, qmin;
    if (kind == 0) { Kb = (const bf16_t*)(p.ws + WS_KP) + (size_t)(b * 4 + h) * TP * 128; Vb = (const bf16_t*)(p.ws + WS_VTP) + (size_t)(b * 4 + h) * TP * 128; KN = (const float*)(p.ws + WS_KNP) + (size_t)(b * 4 + h) * 256;
        ntiles = 2 * qb + 2; nkb = (2 * qb + (rg >> 1) + 1) * 2; rowbase = b * TP + qb * 128 + rg * 32; qpos0 = qb * 128 + rg * 32; qmin = qb * 128; }
    else { Kb = (const bf16_t*)(p.ws + WS_KS) + (size_t)(b * 4 + h) * TSP * 128; Vb = (const bf16_t*)(p.ws + WS_VTS) + (size_t)(b * 4 + h) * TSP * 128; KN = (const float*)(p.ws + WS_KNS) + (size_t)(b * 4 + h) * 256;
        ntiles = TSP / 64; nkb = (rg == 0) ? (PAST + TSQ) / 32 : 0; rowbase = MP + b * TSQ; qpos0 = PAST; qmin = PAST; }
    const bool active = nkb > 0;
    const bf16_t* kg = Kb + (size_t)tid * 8;
    const bf16_t* vg = Vb + (size_t)tid * 8;
    const int kl0 = (tid >> 4) * ATT_KROW + (tid & 15) * 16, vl0 = ATT_VOFF + (tid >> 3) * ATT_VROW + (tid & 7) * 16;
    u32x4 rA0, rA1, rA2, rA3, rB0, rB1, rB2, rB3;
#define ATT_LOAD(t, r0, r1, r2, r3) do { const bf16_t* _k = kg + (size_t)(t) * 8192; r0 = *(const u32x4*)_k; r1 = *(const u32x4*)(_k + 4096); const bf16_t* _v = vg + (size_t)(t) * 8192; r2 = *(const u32x4*)_v; r3 = *(const u32x4*)(_v + 4096); } while (0)
#define ATT_WRITE(buf, r0, r1, r2, r3) do { LAS unsigned char* _b = lds + (buf) * ATT_BUF; *(LAS u32x4*)(_b + kl0) = r0; *(LAS u32x4*)(_b + kl0 + 32 * ATT_KROW) = r1; \
        *(LAS u32x4*)(_b + vl0) = r2; *(LAS u32x4*)(_b + vl0 + 64 * ATT_VROW) = r3; } while (0)
    ATT_LOAD(ntiles - 1, rA0, rA1, rA2, rA3);
    ATT_LOAD(ntiles - 2, rB0, rB1, rB2, rB3);
    const float kn0 = (rg == 0 && 2 * lane < ntiles) ? KN[c * 128 + 2 * lane] : 0.f, kn1 = (rg == 0 && 2 * lane + 1 < ntiles) ? KN[c * 128 + 2 * lane + 1] : 0.f;
    bf16x8 qf[4];
#pragma unroll
    for (int ks = 0; ks < 4; ++ks) qf[ks] = *(const bf16x8*)(Qg + (size_t)(rowbase + cq) * 512 + h * 128 + c * 64 + ks * 16 + hh * 8);
    const float sl2 = exp2f(-2.0f * (float)(h + 1)) * LOG2E;
    LAS float* pmt = (LAS float*)(lds + ATT_PMT); LAS float* pub = (LAS float*)(lds + ATT_PUB);
    {
        float qs = 0.f;
#pragma unroll
        for (int ks = 0; ks < 4; ++ks)
#pragma unroll
            for (int j = 0; j < 8; ++j) { const float v = __uint_as_float(((unsigned)(unsigned short)qf[ks][j]) << 16); qs += v * v; }
        qs += __shfl_xor(qs, 32);
#pragma unroll
        for (int o = 16; o >= 1; o >>= 1) qs = fmaxf(qs, __shfl_xor(qs, o));
        if (lane == 0) pub[wave] = active ? qs : 0.f;
        if (rg == 0) {
            const float k0 = kn0; float k1 = fmaxf(kn0, kn1);
            float run = k1;
#pragma unroll
            for (int o = 1; o < 64; o <<= 1) { const float up = __shfl_up(run, o); if (lane >= o) run = fmaxf(run, up); }
            const float prev = __shfl_up(run, 1);
            pmt[c * 128 + 2 * lane] = fmaxf(k0, lane > 0 ? prev : 0.f); pmt[c * 128 + 2 * lane + 1] = run;
        }
    }
    f32x16 O[4];
#pragma unroll
    for (int d = 0; d < 4; ++d)
#pragma unroll
        for (int e = 0; e < 16; ++e) O[d][e] = 0.f;
    float mrun = -1e30f, lrun = 0.f;
    ATT_WRITE(0, rA0, rA1, rA2, rA3);
    __syncthreads();
    const float qn0 = sqrtf(fmaxf(fmaxf(pub[0], pub[1]), fmaxf(pub[2], pub[3]))), qn1 = sqrtf(fmaxf(fmaxf(pub[4], pub[5]), fmaxf(pub[6], pub[7])));
    float mlb0 = 0.f, mlb1 = 0.f;
    int NT = ntiles;
#define ATT_STEP(n, N0, N1, N2, N3, O0, O1, O2, O3) do { \
        if ((n) + 2 < NT) { \
            bool drop = false; \
            if ((n) >= 2) { const int tn = ntiles - 3 - (n); const float dmin = sl2 * (float)(qmin - (tn * 64 + 63)); \
                const float ub0 = qn0 * sqrtf(pmt[tn]) - dmin, ub1 = qn1 * sqrtf(pmt[128 + tn]) - dmin; \
                drop = (ub0 < mlb0 - ATT_SKIP) && (ub1 < mlb1 - ATT_SKIP); } \
            if (drop) NT = (n) + 2; else ATT_LOAD(ntiles - 3 - (n), N0, N1, N2, N3); \
        } \
        att_compute(lds + ((n) & 1) * ATT_BUF, ntiles - 1 - (n), nkb, qpos0, cq, hh, c, sl2, qf, O, mrun, lrun); \
        if ((n) == 1) { float mm = active ? mrun : 1e30f; \
            _Pragma("unroll") for (int o = 16; o >= 1; o >>= 1) mm = fminf(mm, __shfl_xor(mm, o)); \
            if (lane == 0) pub[8 + wave] = mm; } \
        if ((n) + 1 < NT) ATT_WRITE(((n) + 1) & 1, O0, O1, O2, O3); \
        __syncthreads(); \
        if ((n) == 1) { mlb0 = fminf(fminf(pub[8], pub[9]), fminf(pub[10], pub[11])); mlb1 = fminf(fminf(pub[12], pub[13]), fminf(pub[14], pub[15])); } \
    } while (0)
    for (int n = 0; n < NT; n += 2) {
        ATT_STEP(n, rA0, rA1, rA2, rA3, rB0, rB1, rB2, rB3);
        if (n + 1 >= NT) break;
        ATT_STEP(n + 1, rB0, rB1, rB2, rB3, rA0, rA1, rA2, rA3);
    }
#undef ATT_STEP
#undef ATT_LOAD
#undef ATT_WRITE
    int nxt_ticket = 0;
    if (tid == 0) nxt_ticket = (int)atomicAdd(qcnt, 1u);
    const float lt = lrun + __shfl_xor(lrun, 32);
    const float inv = active ? 1.0f / lt : 0.0f;
    LAS float* ex = (LAS float*)lds + ((rg * 128 + 4 * hh) * 32 + cq);
    if (c == 1) {
#pragma unroll
        for (int d = 0; d < 4; ++d)
#pragma unroll
            for (int e = 0; e < 16; ++e) ex[(d * 32 + (e & 3) + 8 * (e >> 2)) * 32] = O[d][e] * inv;
    }
    LAS float* sgl = (LAS float*)(lds + 65536 + 4 * (32 * 272));
    if (tid < 128) sgl[tid] = p.in[I_SUBG][tid];
    __syncthreads();
    if (c == 0) {
        float ss = 0.f;
#pragma unroll
        for (int d = 0; d < 4; ++d)
#pragma unroll
            for (int e = 0; e < 16; ++e) { const float o = O[d][e] * inv - lam * ex[(d * 32 + (e & 3) + 8 * (e >> 2)) * 32]; O[d][e] = o; ss += o * o; }
        ss += __shfl_xor(ss, 32);
        const float rn = rsqrtf(ss * (1.0f / 128.0f) + RMS_EPS) * 0.8f;
        LAS unsigned char* stg = lds + 65536 + rg * (32 * 272);
        LAS unsigned char* sb = stg + cq * 272 + 8 * hh; const LAS float* sgb = sgl + 4 * hh;
#pragma unroll
        for (int d = 0; d < 4; ++d)
#pragma unroll
            for (int e = 0; e < 16; e += 2) { const int dc = d * 32 + (e & 3) + 8 * (e >> 2);
                *(LAS unsigned*)(sb + dc * 2) = pk_bf16(O[d][e] * rn * sgb[dc], O[d][e + 1] * rn * sgb[dc + 1]); }
        asm volatile("s_waitcnt lgkmcnt(0)" ::: "memory");
        if (active) {
            bf16_t* MIX = (bf16_t*)(p.ws + WS_C);
#pragma unroll
            for (int it = 0; it < 8; ++it) { const int row = it * 4 + (lane >> 4), seg = lane & 15;
                const u32x4 wv = *(const LAS u32x4*)(stg + row * 272 + seg * 16);
                *(u32x4*)(MIX + (size_t)(rowbase + row) * DM + h * 128 + seg * 8) = wv; }
        }
    }
    if (tid == 0) *slot = nxt_ticket;
    __syncthreads();
}

#define XB_TMO      128
#define XB_XCNT(j)  (256  + 64 * (j))
#define XB_XSUB(j)  (1280 + 64 * (j))
#define XB_XGEN(j)  (2304 + 64 * (j))
#define XB_TOP      3328
#define XB_TOPGEN   3392
#define XCD_BAR_WORDS 3456
#define XB_SPIN_CAP (1u << 20)
DI unsigned xb_ld(unsigned* p)              { return __hip_atomic_load(p, __ATOMIC_RELAXED, __HIP_MEMORY_SCOPE_AGENT); }
DI unsigned xb_add(unsigned* p, unsigned v) { return __hip_atomic_fetch_add(p, v, __ATOMIC_RELAXED, __HIP_MEMORY_SCOPE_AGENT); }
DI unsigned xb_xcc_id() { return (unsigned)__builtin_amdgcn_s_getreg((3 << 11) | 20) & 0xFu; }
#define XB_SPIN(cond, bar) do { unsigned _sp = 0; while (cond) { __builtin_amdgcn_s_sleep(1); \
    if ((++_sp & 255u) == 0u) { if (xb_ld(&(bar)[XB_TMO])) break; if (_sp > XB_SPIN_CAP) { atomicAdd(&(bar)[XB_TMO], 1u); break; } } } } while (0)
struct XcdBarrier { unsigned* bar; unsigned x; volatile LAS unsigned* st; };
DI XcdBarrier xcd_barrier_post(unsigned* bar, volatile LAS unsigned* st) {
    XcdBarrier b; b.bar = bar; b.x = xb_xcc_id(); b.st = st;
    if (threadIdx.x == 0) (void)xb_add(&bar[XB_XCNT(b.x)], 1u);
    return b;
}
DI void xcd_barrier_complete(unsigned* bar, unsigned x, unsigned& nloc, unsigned& nx) {
    const unsigned G = gridDim.x * gridDim.y * gridDim.z;
    unsigned sum, cnt, mine, sp = 0u;
    for (;;) {
        sum = 0u; cnt = 0u; mine = 0u;
#pragma unroll
        for (unsigned j = 0; j < 16; ++j) { const unsigned c = xb_ld(&bar[XB_XCNT(j)]); sum += c; cnt += (c > 0u) ? 1u : 0u; mine = (j == x) ? c : mine; }
        if (sum == G) break;
        __builtin_amdgcn_s_sleep(1);
        if ((++sp & 255u) == 0u) { if (xb_ld(&bar[XB_TMO])) break; if (sp > XB_SPIN_CAP) { atomicAdd(&bar[XB_TMO], 1u); break; } }
    }
    nloc = mine > 0u ? mine : 1u; nx = cnt > 0u ? cnt : 1u;
}
DI void xcd_barrier(const XcdBarrier& b) {
    asm volatile("s_waitcnt vmcnt(0)" ::: "memory");
    __syncthreads();
    if (threadIdx.x == 0) {
        unsigned* bar = b.bar;
        __builtin_amdgcn_s_waitcnt(0);
        unsigned nloc = b.st[0], nx = b.st[1];
        if (nloc == 0u) { xcd_barrier_complete(bar, b.x, nloc, nx); b.st[0] = nloc; b.st[1] = nx; }
        const unsigned old = xb_add(&bar[XB_XSUB(b.x)], 1u);
        const unsigned gen = old / nloc;
        if (old + 1u == (gen + 1u) * nloc) {
            __builtin_amdgcn_fence(__ATOMIC_RELEASE, "agent");
            asm volatile("s_waitcnt vmcnt(0)" ::: "memory");
            const unsigned og = xb_add(&bar[XB_TOP], 1u);
            const unsigned tg = og / nx;
            if (og + 1u == (tg + 1u) * nx) xb_add(&bar[XB_TOPGEN], 1u);
            else XB_SPIN(xb_ld(&bar[XB_TOPGEN]) == tg, bar);
            __builtin_amdgcn_fence(__ATOMIC_ACQUIRE, "agent");
            xb_add(&bar[XB_XGEN(b.x)], 1u);
            asm volatile("s_waitcnt vmcnt(0)" ::: "memory");
        } else {
            XB_SPIN(xb_ld(&bar[XB_XGEN(b.x)]) == gen, bar);
            __builtin_amdgcn_fence(__ATOMIC_ACQUIRE, "agent");
            asm volatile("s_waitcnt vmcnt(0)" ::: "memory");
        }
    }
    __syncthreads();
}

__global__ void __launch_bounds__(NTHREADS, 2) fwd_megakernel(Params p) {
    extern __shared__ __attribute__((aligned(16))) unsigned char lds_raw[];
    LAS unsigned char* lds = (LAS unsigned char*)lds_raw;
    volatile LAS unsigned* xst = (volatile LAS unsigned*)(lds + LDS_CTL + 16);
    if (threadIdx.x < 2) xst[threadIdx.x] = 0u;
    __syncthreads();
    const XcdBarrier xbar = xcd_barrier_post((unsigned*)(p.ws + WS_BAR), xst);
    const int lo = p.ph_lo, hi = p.ph_hi;
    const int G = gridDim.x, bid = blockIdx.x;
    unsigned char* ws = p.ws;
    bf16_t* XN = (bf16_t*)(ws + WS_C); bf16_t* Hb = (bf16_t*)(ws + WS_A); bf16_t* Dh = (bf16_t*)(ws + WS_B); float* PART = (float*)(ws + WS_B + SZ_XN);    float* Y = p.out + OUT_Y;
#define IN(k) (lo <= (k) && (k) < hi)
#define SEAM(k) do { asm volatile("" ::: "memory"); if ((k) + 1 < hi) xcd_barrier(xbar); asm volatile("" ::: "memory"); } while (0)

    if (IN(0)) {
        convert_weights_p0(p, lds);
        if (bid == 0 && threadIdx.x == 0) __hip_atomic_store((unsigned*)(ws + WS_CNT) + 2, 0u, __ATOMIC_RELAXED, __HIP_MEMORY_SCOPE_AGENT);
        row_phase<0>(p, nullptr, nullptr, 0, nullptr, XN, nullptr, p.in[I_G1A], 0.f, true);
        SEAM(0);
    }
    if (IN(1)) {
        pg8::Gemm g{XN, (const bf16_t*)(ws + WS_WGU1), MT, 2 * DFF, DM}; pg8::StaticOrder S; S.init(MT, 2 * DFF, DM, G, bid);
        pg8::EpiSwiglu E{Hb};
        pg8::gemm_phase<pg8::EpiSwiglu, pg8::StaticOrder>(lds, g, S, E);
        filler_loop<0>(p, lds, (unsigned*)(ws + WS_CNT) + 2, NWT_FFN1UP, NWT_ALL);
        SEAM(1);
    }
    if (IN(2)) {
        pg8::Gemm g{Hb, (const bf16_t*)(ws + WS_WD1), MT, DM, DFF}; pg8::SplitOrder S; S.init(DM, DFF, 11, G, bid);
        pg8::EpiDown E{Dh, PART};
        pg8::gemm_phase<pg8::EpiDown, pg8::SplitOrder>(lds, g, S, E);
        SEAM(2);
    }
    if (IN(3)) {
        row_phase<1>(p, Dh, PART, 11, Y, XN, p.in[I_G1B], p.in[I_GMA], 0.5f, true);
        if (bid == 0 && threadIdx.x == 0) __hip_atomic_store((unsigned*)(ws + WS_CNT) + 3, 0u, __ATOMIC_RELAXED, __HIP_MEMORY_SCOPE_AGENT);
        SEAM(3);
    }
    if (IN(4)) {
        pg8::Gemm g{XN, (const bf16_t*)(ws + WS_WIN), MT, DIN, DM}; pg8::StaticOrder S; S.init(MT, DIN, DM, G, bid);
        pg8::EpiInProj E{(bf16_t*)(ws + WS_Q), (bf16_t*)(ws + WS_KP), (bf16_t*)(ws + WS_KS), (bf16_t*)(ws + WS_VTP), (bf16_t*)(ws + WS_VTS), (bf16_t*)(ws + WS_GG), (float*)(ws + WS_LX), p.out};
        pg8::gemm_phase<pg8::EpiInProj, pg8::StaticOrder>(lds, g, S, E);
        filler_loop<1>(p, lds, (unsigned*)(ws + WS_CNT) + 3, 0, NCU_ALL);
        SEAM(4);
    }
    if (IN(5)) {
        { LruConst lk; lru_load_const(p, lk);
          for (int it = bid; it < NBP * 128 + NBS; it += G) lru_local_item(p, lds, it, lk); }
        knorm_items(p);
        if (bid == 0 && threadIdx.x < 2) __hip_atomic_store((unsigned*)(ws + WS_CNT) + threadIdx.x, 0u, __ATOMIC_RELAXED, __HIP_MEMORY_SCOPE_AGENT);
        SEAM(5);
    }
    if (IN(6)) {
        const int lane = threadIdx.x & 63;
        const float lam = __expf(wave_sum(p.in[I_LQ1][lane] * p.in[I_LK1][lane])) - __expf(wave_sum(p.in[I_LQ2][lane] * p.in[I_LK2][lane])) + 0.2f;
        if (bid < NBP) lru_carry_scan(p, bid);
        unsigned* qcnt = (unsigned*)(ws + WS_CNT);
        LAS int* slot = (LAS int*)(lds + LDS_CTL);
        constexpr int NQ_S = NBS * 4, NQ_P = NBP * 4 * 64, NQ_L = NBP * 128 + NBS;
        if (threadIdx.x == 0) *slot = (int)atomicAdd(qcnt, 1u);
        __syncthreads();
        for (;;) {
            const int idx = *slot;
            if (idx >= NQ_S + NQ_P + NQ_L) break;
            if (idx < NQ_S + NQ_P) {
                int kind, b, h, qb;
                if (idx < NQ_S) { kind = 1; b = idx & 7; h = 3 - (idx >> 3); qb = 0; }
                else { const int j = idx - NQ_S, r = j & 255; kind = 0; b = r & 3; h = 3 - (j >> 8); qb = 63 - (r >> 2); }
                attn_item(p, lds, kind, b, h, qb, lam, qcnt, slot);
            } else { __syncthreads(); lru_final_item(p, idx - NQ_S - NQ_P); if (threadIdx.x == 0) *slot = (int)atomicAdd(qcnt, 1u); __syncthreads(); }
        }
        SEAM(6);
    }
    if (IN(7)) {
        pg8::Gemm g{XN  , (const bf16_t*)(ws + WS_WOUT), MT, DM, DM}; pg8::SplitOrder S; S.init(DM, DM, 4, G, bid);
        pg8::EpiDown E{Dh, PART};
        pg8::gemm_phase<pg8::EpiDown, pg8::SplitOrder>(lds, g, S, E);
        SEAM(7);
    }
    if (IN(8)) { row_phase<1>(p, Dh, PART, 4, Y, XN, p.in[I_GMB], p.in[I_G2A], 1.0f, false); SEAM(8); }
    if (IN(9)) {
        pg8::Gemm g{XN, (const bf16_t*)(ws + WS_WGU2), MT, 2 * DFF, DM}; pg8::StaticOrder S; S.init(MT, 2 * DFF, DM, G, bid);
        pg8::EpiSwiglu E{Hb};
        pg8::gemm_phase<pg8::EpiSwiglu, pg8::StaticOrder>(lds, g, S, E);
        SEAM(9);
    }
    if (IN(10)) {
        pg8::Gemm g{Hb, (const bf16_t*)(ws + WS_WD2), MT, DM, DFF}; pg8::SplitOrder S; S.init(DM, DFF, 11, G, bid);
        pg8::EpiDown E{Dh, PART};
        pg8::gemm_phase<pg8::EpiDown, pg8::SplitOrder>(lds, g, S, E);
        SEAM(10);
    }
    if (IN(11)) row_phase<2>(p, Dh, PART, 11, Y, nullptr, p.in[I_G2B], nullptr, 0.5f, false);
#undef IN
#undef SEAM
}

constexpr int N_PHASES = 12;
#define LAUNCH_RANGES {0, N_PHASES}

extern "C" void kernel_launch(void* const* d_in, const int* in_sizes, int n_in, void* d_out, int out_size, void* d_ws, size_t ws_size, hipStream_t stream) {
    static int grid_blocks = 0;
    if (grid_blocks == 0) {
        if (n_in != 32 || ws_size < WS_END) { fprintf(stderr, "kernel_launch: need 32 inputs and >= %zu bytes of workspace (got %d, %zu)\n", (size_t)WS_END, n_in, ws_size); grid_blocks = -1; return; }
        int dev = 0, cus = 0, per_cu = 0;
        hipGetDevice(&dev);
        hipDeviceGetAttribute(&cus, hipDeviceAttributeMultiprocessorCount, dev);
        if (hipFuncSetAttribute((const void*)fwd_megakernel, hipFuncAttributeMaxDynamicSharedMemorySize, LDS_BYTES) != hipSuccess) { fprintf(stderr, "kernel_launch: hipFuncSetAttribute failed\n"); grid_blocks = -1; return; }
        if (hipOccupancyMaxActiveBlocksPerMultiprocessor(&per_cu, (const void*)fwd_megakernel, NTHREADS, LDS_BYTES) != hipSuccess || per_cu < 1) { fprintf(stderr, "kernel_launch: occupancy query failed (%d)\n", per_cu); grid_blocks = -1; return; }
        grid_blocks = cus * per_cu;
    }
    if (grid_blocks < 0) return;
    Params p{};
    for (int i = 0; i < 32; ++i) p.in[i] = (const float*)d_in[i];
    p.out = (float*)d_out; p.ws = (unsigned char*)d_ws;
    static const int ranges[][2] = {LAUNCH_RANGES};
    for (unsigned li = 0; li < sizeof(ranges) / sizeof(ranges[0]); ++li) {
        p.ph_lo = ranges[li][0]; p.ph_hi = ranges[li][1];
        if (hipMemsetAsync((unsigned char*)d_ws + WS_BAR, 0, 16384, stream) != hipSuccess) { fprintf(stderr, "kernel_launch: hipMemsetAsync failed\n"); return; }
        void* args[] = {&p};
        hipError_t e = hipLaunchCooperativeKernel((const void*)fwd_megakernel, dim3(grid_blocks), dim3(NTHREADS), args, LDS_BYTES, stream);
        if (e != hipSuccess) fprintf(stderr, "cooperative launch failed: %s (grid %d)\n", hipGetErrorString(e), grid_blocks);
    }
}
```

```cpp
#include <hip/hip_runtime.h>
#include <hip/hip_cooperative_groups.h>
#include <cstdio>
namespace cg = cooperative_groups;

#define LAS __attribute__((address_space(3)))
#define DI __device__ __forceinline__
typedef unsigned short bf16_t;
typedef short bf16x8 __attribute__((ext_vector_type(8)));
typedef float f32x2 __attribute__((ext_vector_type(2)));
typedef float f32x4 __attribute__((ext_vector_type(4)));
typedef float f32x16 __attribute__((ext_vector_type(16)));
typedef unsigned u32x2 __attribute__((ext_vector_type(2)));
typedef unsigned u32x4 __attribute__((ext_vector_type(4)));
typedef __bf16 bf16x2n __attribute__((ext_vector_type(2)));

constexpr int DM = 1024, TP = 8192, NBP = 4, NBS = 8, TSQ = 32, PAST = 4096, DFF = 2816, DIN = 2560;
constexpr int MP = NBP * TP, MS = NBS * TSQ, MT = MP + MS;
constexpr int TSP = 4160;
constexpr int NTHREADS = 512;
constexpr int LDS_CTL = 139264;
constexpr int LDS_BYTES = LDS_CTL + 64;
constexpr float RMS_EPS = 1e-6f;
constexpr float LOG2E = 1.4426950408889634f;

constexpr size_t SZ_H = (size_t)MT * DFF * 2, SZ_D = (size_t)MT * DM * 4, SZ_XN = (size_t)MT * DM * 2;
constexpr size_t WS_A = 0;
constexpr size_t WS_B = WS_A + SZ_H;
constexpr size_t WS_C = WS_B + SZ_D;
constexpr size_t WS_W = WS_C + SZ_XN;
constexpr size_t SZ_WGU = (size_t)2 * DFF * DM * 2, SZ_WD = (size_t)DM * DFF * 2, SZ_WIN = (size_t)DIN * DM * 2, SZ_WOUT = (size_t)DM * DM * 2, SZ_WG = (size_t)64 * 512 * 2;
constexpr size_t WS_WGU1 = WS_W, WS_WD1 = WS_WGU1 + SZ_WGU, WS_WIN = WS_WD1 + SZ_WD, WS_WOUT = WS_WIN + SZ_WIN, WS_WGU2 = WS_WOUT + SZ_WOUT, WS_WD2 = WS_WGU2 + SZ_WGU;
constexpr size_t WS_WRT = WS_WD2 + SZ_WD, WS_WIT = WS_WRT + SZ_WG;
constexpr size_t WS_PP = WS_WIT + SZ_WG;
constexpr size_t WS_HL = WS_PP + (size_t)MT * 512 * 2;
constexpr size_t WS_AP = WS_HL + (size_t)MT * 512 * 2;
constexpr size_t WS_HE = WS_AP + (size_t)12 * 128 * 512 * 4;
constexpr size_t WS_KNP = WS_HE + (size_t)12 * 128 * 512 * 4;
constexpr size_t WS_KNS = WS_KNP + (size_t)NBP * 4 * 2 * 128 * 4;
constexpr size_t WS_CNT = WS_KNS + (size_t)NBS * 4 * 2 * 128 * 4;
constexpr size_t WS_CAR = WS_CNT + 256;
constexpr size_t WS_BAR = WS_CAR + (size_t)NBP * 128 * 512 * 4;
constexpr size_t WS_END = WS_BAR + 16384;
constexpr size_t WS_Q = WS_A, WS_KP = WS_Q + (size_t)MT * 512 * 2, WS_KS = WS_KP + (size_t)MP * 512 * 2, WS_VTP = WS_KS + (size_t)NBS * TSP * 512 * 2, WS_VTS = WS_VTP + (size_t)MP * 512 * 2;
static_assert(WS_VTS + (size_t)NBS * 512 * TSP * 2 <= WS_B, "region A overflow");
constexpr size_t WS_LX = WS_B, WS_GG = WS_LX + (size_t)MT * 512 * 4;
static_assert(WS_GG + (size_t)MT * 512 * 2 <= WS_C, "region B overflow");

constexpr size_t OUT_Y = 0, OUT_KP = (size_t)MT * DM, OUT_VP = OUT_KP + (size_t)MP * 512, OUT_LHP = OUT_VP + (size_t)MP * 512, OUT_CVP = OUT_LHP + NBP * 512,
                 OUT_KS = OUT_CVP + NBP * 3 * 512, OUT_VS = OUT_KS + (size_t)MS * 512, OUT_LHS = OUT_VS + (size_t)MS * 512, OUT_CVS = OUT_LHS + NBS * 512;

struct Params { const float* in[32]; float* out; unsigned char* ws; int ph_lo, ph_hi; };

enum { I_XP = 0, I_XS, I_CK, I_CV, I_SH, I_SC, I_WIN, I_WOUT, I_LQ1, I_LK1, I_LQ2, I_LK2, I_SUBG, I_CW, I_CB, I_WR, I_BR, I_WI, I_BI, I_LAM,
       I_F1G, I_F1U, I_F1D, I_F2G, I_F2U, I_F2D, I_G1A, I_G1B, I_GMA, I_GMB, I_G2A, I_G2B };

DI int vpos(int tl) { return (tl & ~12) | ((tl & 4) << 1) | ((tl & 8) >> 1); }
DI int phase_tid() { int t = threadIdx.x; asm volatile("" : "+v"(t)); return t; }
DI unsigned pk_bf16(float a, float b) { f32x2 v = {a, b}; bf16x2n r = __builtin_convertvector(v, bf16x2n); return __builtin_bit_cast(unsigned, r); }
DI float bf2f(bf16_t v) { return __uint_as_float(((unsigned)v) << 16); }
DI float wave_sum(float v) {
#pragma unroll
    for (int o = 32; o >= 1; o >>= 1) v += __shfl_xor(v, o);
    return v; }
DI float sigmoidf_(float x) { return __builtin_amdgcn_rcpf(1.0f + __expf(-x)); }
DI float gelu_tanh(float x) { const float u = 0.7978845608028654f * (x + 0.044715f * x * x * x); return x * __builtin_amdgcn_rcpf(1.0f + __expf(-2.0f * u)); }

namespace pg8 {
constexpr int BM = 256, BK = 64, HALF = 128, HTB = HALF * BK * 2, STAGE_BYTES = 8 * HTB, NXCD = 8, WGM = 8;
DI int lds_byte(int r, int c) { const int st = (r >> 4) * 2 + (c >> 5), rr = r & 15, cc = c & 31, ob = rr * 64 + cc * 2; return st * 1024 + (ob ^ (((ob >> 9) & 1) << 5)); }
DI void stage_rc(int b, int& R, int& C) { const int st = b / 1024, sb = b % 1024, swz = sb ^ (((sb >> 9) & 1) << 5); R = (st >> 1) * 16 + swz / 64; C = (st & 1) * 32 + (swz % 64) / 2; }
DI int perm32(int rho) { const int n = rho >> 4, i = rho & 15; return 8 * (i >> 2) + 4 * n + (i & 3); }
struct Unit { int pm, pn, k0, nt, part; };
struct Gemm { const bf16_t* A; const bf16_t* Bt; int M, N, K; };
struct StaticOrder {
    int nM, nN, nwg, G, c, ntk;
    DI void init(int M, int N, int K, int G_, int c_) { nM = M / BM; nN = N / BM; nwg = nM * nN; G = G_; c = c_; ntk = K / BK; }
    DI bool next(int i, Unit& u) const {
        const long L = (long)i * G + c; if (L >= nwg) return false;
        int wgid = (int)L; { const int q = nwg / NXCD, r = nwg % NXCD, xcd = wgid % NXCD, off = wgid / NXCD; wgid = (xcd < r ? xcd * (q + 1) : r * (q + 1) + (xcd - r) * q) + off; }
        const int nig = WGM * nN, gid = wgid / nig, fm = gid * WGM, gsz = (nM - fm) < WGM ? (nM - fm) : WGM;
        u.pm = fm + ((wgid % nig) % gsz); u.pn = (wgid % nig) / gsz; u.k0 = 0; u.nt = ntk; u.part = -1; return true;
    }
    DI void a_ready(const Unit&) const {}
    DI void done(const Unit&) const {}
};
struct SplitOrder {
    StaticOrder P; int nN, ksplit, ntc, G, c;
    DI void init(int N, int K, int ksplit_, int G_, int c_) { P.init(MP, N, K, G_, c_); nN = N / BM; ksplit = ksplit_; ntc = K / BK / ksplit_; G = G_; c = c_; }
    DI bool next(int i, Unit& u) const {
        const long L = (long)i * G + c;
        if (L < P.nwg) return P.next(i, u);
        const int j = (int)(L - P.nwg); if (j >= nN * ksplit) return false;
        const int ks = j / nN; u.pm = MP / BM; u.pn = j % nN; u.k0 = ks * ntc * BK; u.nt = ntc; u.part = ks; return true;
    }
    DI void a_ready(const Unit&) const {}
    DI void done(const Unit&) const {}
};

template <class Epi, class Sched, bool ALIGN_EPI = true, bool SP2 = true>
DI void gemm_phase(LAS unsigned char* lds, const Gemm g, const Sched& S, const Epi& E) {
    const int tid = phase_tid(), wid = __builtin_amdgcn_readfirstlane(tid >> 6), lane = tid & 63, wr = wid >> 2, wc = wid & 3, fr = lane & 15, fq = lane >> 4;
    const int K = g.K;
    unsigned voffA[2], voffB[2];
#pragma unroll
    for (int i = 0; i < 2; ++i) { int R, C; stage_rc(tid * 16 + i * 8192, R, C); const int Rb = Epi::PERM ? ((R & ~31) + perm32(R & 31)) : R;
        voffA[i] = (unsigned)(R * K + C) * 2u; voffB[i] = (unsigned)(Rb * K + C) * 2u; }
    const size_t kstep = (size_t)(BK * 2);
    const size_t hstep = (size_t)HALF * K * 2;
    const size_t tstep = 2 * hstep;
    const unsigned ldsw = (unsigned)wid * 1024u;
    const int aoff = lds_byte(wr * 64 + fr, fq * 8), boff = lds_byte(wc * 32 + fr, fq * 8);
#define PG8_SA(b, h) (((b) * 2 + (h)) * HTB)
#define PG8_SB(b, h) ((4 + (b) * 2 + (h)) * HTB)
#define PG8_STAGE(bufoff, gbase, voff) do { _Pragma("unroll") for (int _i = 0; _i < 2; ++_i) \
        __builtin_amdgcn_global_load_lds((const unsigned*)((const char*)(gbase) + (voff)[_i]), (LAS unsigned*)(lds + (bufoff) + ldsw + _i * 8192), 16, 0, 0); } while (0)
#define PG8_LDA(dst, b, h) do { _Pragma("unroll") for (int m = 0; m < 4; ++m) _Pragma("unroll") for (int k = 0; k < 2; ++k) dst[m][k] = *(const LAS bf16x8*)(lds + PG8_SA(b, h) + aoff + m * 2048 + k * 1024); } while (0)
#define PG8_LDB(dst, b, h) do { _Pragma("unroll") for (int n = 0; n < 2; ++n) _Pragma("unroll") for (int k = 0; k < 2; ++k) dst[n][k] = *(const LAS bf16x8*)(lds + PG8_SB(b, h) + boff + n * 2048 + k * 1024); } while (0)
#define PG8_MMA(ai, bj, At, Bt) do { __builtin_amdgcn_s_setprio(1); _Pragma("unroll") for (int m = 0; m < 4; ++m) _Pragma("unroll") for (int n = 0; n < 2; ++n) _Pragma("unroll") for (int k = 0; k < 2; ++k) \
        acc[ai][bj][m][n] = __builtin_amdgcn_mfma_f32_16x16x32_bf16(Bt[n][k], At[m][k], acc[ai][bj][m][n], 0, 0, 0); __builtin_amdgcn_s_setprio(0); } while (0)
#define PG8_WAIT_V(n) asm volatile("s_waitcnt vmcnt(" #n ")" ::: "memory")
#define PG8_WAIT_L(n) asm volatile("s_waitcnt lgkmcnt(" #n ")" ::: "memory")
#define PG8_BAR __builtin_amdgcn_s_barrier()
#define PG8_SCHED __builtin_amdgcn_sched_barrier(0)
    Unit cur, nxt; int ui = 0;
    if (!S.next(0, cur)) return;
    f32x4 acc[2][2][4][2];
#pragma unroll
    for (int a = 0; a < 2; ++a)
#pragma unroll
        for (int b = 0; b < 2; ++b)
#pragma unroll
            for (int m = 0; m < 4; ++m)
#pragma unroll
                for (int n = 0; n < 2; ++n) acc[a][b][m][n] = (f32x4){0.f, 0.f, 0.f, 0.f};
    bf16x8 At[4][2], B0[2][2], B1[2][2];
    const char* cA = (const char*)g.A + (size_t)cur.pm * tstep + (size_t)cur.k0 * 2; const char* cB = (const char*)g.Bt + (size_t)cur.pn * tstep + (size_t)cur.k0 * 2;
    S.a_ready(cur);
    if constexpr (SP2) {
        PG8_STAGE(PG8_SB(0, 0), cB, voffB); PG8_STAGE(PG8_SB(0, 1), cB + hstep, voffB); PG8_STAGE(PG8_SA(0, 0), cA, voffA); PG8_STAGE(PG8_SA(0, 1), cA + hstep, voffA);
        if (wr == 1) PG8_BAR;
        PG8_WAIT_V(2); PG8_BAR;
        PG8_STAGE(PG8_SB(1, 0), cB + kstep, voffB); PG8_STAGE(PG8_SA(1, 0), cA + kstep, voffA); PG8_STAGE(PG8_SB(1, 1), cB + hstep + kstep, voffB);
        PG8_WAIT_V(6); PG8_BAR;
    } else {
        PG8_STAGE(PG8_SB(0, 0), cB, voffB); PG8_STAGE(PG8_SA(0, 0), cA, voffA); PG8_STAGE(PG8_SB(0, 1), cB + hstep, voffB); PG8_STAGE(PG8_SA(0, 1), cA + hstep, voffA);
        if (wr == 1) PG8_BAR;
        PG8_WAIT_V(4); PG8_BAR;
        PG8_STAGE(PG8_SB(1, 0), cB + kstep, voffB); PG8_STAGE(PG8_SA(1, 0), cA + kstep, voffA); PG8_STAGE(PG8_SB(1, 1), cB + hstep + kstep, voffB);
        PG8_WAIT_V(6); PG8_BAR;
    }
    for (;;) {
        const bool has_next = S.next(ui + 1, nxt);
        const char* nA = has_next ? (const char*)g.A + (size_t)nxt.pm * tstep + (size_t)nxt.k0 * 2 : cA; const char* nB = has_next ? (const char*)g.Bt + (size_t)nxt.pn * tstep + (size_t)nxt.k0 * 2 : cB;
        const int nt = cur.nt;
        for (int t = 0; t < nt; t += 2) {
            const bool last = (t == nt - 2);
            const char* a1 = cA + (size_t)(t + 1) * kstep;
            const char* a2 = last ? nA : cA + (size_t)(t + 2) * kstep; const char* b2 = last ? nB : cB + (size_t)(t + 2) * kstep;
            const char* a3 = a2 + kstep; const char* b3 = b2 + kstep;
            if (last && has_next) S.a_ready(nxt);
            if constexpr (SP2) {
            PG8_LDB(B0, 0, 0); PG8_LDB(B1, 0, 1); PG8_SCHED; PG8_LDA(At, 0, 0); PG8_STAGE(PG8_SA(1, 1), a1 + hstep, voffA);
            PG8_WAIT_V(8); PG8_WAIT_L(0); PG8_BAR; PG8_MMA(0, 0, At, B0); PG8_MMA(0, 1, At, B1); PG8_BAR; PG8_SCHED;
            PG8_LDA(At, 0, 1); PG8_STAGE(PG8_SB(0, 0), b2, voffB); PG8_STAGE(PG8_SB(0, 1), b2 + hstep, voffB); PG8_STAGE(PG8_SA(0, 0), a2, voffA);
            PG8_WAIT_V(8); PG8_WAIT_L(0); PG8_BAR; PG8_MMA(1, 0, At, B0); PG8_MMA(1, 1, At, B1); PG8_BAR; PG8_SCHED;
            PG8_LDB(B0, 1, 0); PG8_LDB(B1, 1, 1); PG8_SCHED; PG8_LDA(At, 1, 0); PG8_STAGE(PG8_SA(0, 1), a2 + hstep, voffA);
            PG8_WAIT_V(8); PG8_WAIT_L(0); PG8_BAR; PG8_MMA(0, 0, At, B0); PG8_MMA(0, 1, At, B1); PG8_BAR; PG8_SCHED;
            PG8_LDA(At, 1, 1); PG8_STAGE(PG8_SB(1, 0), b3, voffB); PG8_STAGE(PG8_SB(1, 1), b3 + hstep, voffB); PG8_STAGE(PG8_SA(1, 0), a3, voffA);
            PG8_WAIT_V(8); PG8_WAIT_L(0); PG8_BAR; PG8_MMA(1, 0, At, B0); PG8_MMA(1, 1, At, B1); PG8_BAR; PG8_SCHED;
            } else {
            PG8_LDB(B0, 0, 0); PG8_SCHED; PG8_LDA(At, 0, 0); PG8_STAGE(PG8_SA(1, 1), a1 + hstep, voffA);
            PG8_WAIT_L(8); PG8_BAR; PG8_WAIT_L(0); PG8_MMA(0, 0, At, B0); PG8_BAR; PG8_SCHED;
            PG8_LDB(B1, 0, 1); PG8_STAGE(PG8_SB(0, 0), b2, voffB);
            PG8_BAR; PG8_WAIT_L(0); PG8_MMA(0, 1, At, B1); PG8_BAR;
            PG8_LDA(At, 0, 1); PG8_STAGE(PG8_SA(0, 0), a2, voffA);
            PG8_BAR; PG8_WAIT_L(0); PG8_MMA(1, 0, At, B0); PG8_BAR; PG8_SCHED;
            PG8_STAGE(PG8_SB(0, 1), b2 + hstep, voffB);
            PG8_WAIT_V(6); PG8_BAR; PG8_MMA(1, 1, At, B1); PG8_BAR;
            PG8_LDB(B0, 1, 0); PG8_SCHED; PG8_LDA(At, 1, 0); PG8_STAGE(PG8_SA(0, 1), a2 + hstep, voffA);
            PG8_WAIT_L(8); PG8_BAR; PG8_WAIT_L(0); PG8_MMA(0, 0, At, B0); PG8_BAR; PG8_SCHED;
            PG8_LDB(B1, 1, 1); PG8_STAGE(PG8_SB(1, 0), b3, voffB);
            PG8_BAR; PG8_WAIT_L(0); PG8_MMA(0, 1, At, B1); PG8_BAR;
            PG8_LDA(At, 1, 1); PG8_STAGE(PG8_SA(1, 0), a3, voffA);
            PG8_BAR; PG8_WAIT_L(0); PG8_MMA(1, 0, At, B0); PG8_BAR; PG8_SCHED;
            PG8_STAGE(PG8_SB(1, 1), b3 + hstep, voffB);
            PG8_WAIT_V(6); PG8_BAR; PG8_MMA(1, 1, At, B1); PG8_BAR;
            }
        }
        if constexpr (ALIGN_EPI) { if (wr == 0) PG8_BAR; }
        E(acc, cur, wr, wc, fr, fq); S.done(cur);
        if (!has_next) break;
#pragma unroll
        for (int a = 0; a < 2; ++a)
#pragma unroll
            for (int b = 0; b < 2; ++b)
#pragma unroll
                for (int m = 0; m < 4; ++m)
#pragma unroll
                    for (int n = 0; n < 2; ++n) acc[a][b][m][n] = (f32x4){0.f, 0.f, 0.f, 0.f};
        cur = nxt; cA = nA; cB = nB; ++ui;
        if constexpr (ALIGN_EPI) { if (wr == 1) PG8_BAR; }
    }
    PG8_WAIT_V(0);
    if constexpr (!ALIGN_EPI) { if (wr == 0) PG8_BAR; }
    PG8_BAR;
#undef PG8_SA
#undef PG8_SB
#undef PG8_STAGE
#undef PG8_LDA
#undef PG8_LDB
#undef PG8_MMA
#undef PG8_WAIT_V
#undef PG8_WAIT_L
#undef PG8_BAR
#undef PG8_SCHED
}

struct EpiF32 {
    static constexpr bool PERM = false;
    float* C; int ldc;
    DI void operator()(const f32x4 (&acc)[2][2][4][2], const Unit& u, int wr, int wc, int fr, int fq) const {
        const int row0 = u.pm * BM + wr * 64 + fr, col0 = u.pn * BM + wc * 32 + 4 * fq;
#pragma unroll
        for (int ai = 0; ai < 2; ++ai)
#pragma unroll
            for (int m = 0; m < 4; ++m) { float* rowp = C + (size_t)(row0 + ai * HALF + m * 16) * ldc + col0;
#pragma unroll
                for (int bj = 0; bj < 2; ++bj)
#pragma unroll
                    for (int n = 0; n < 2; ++n) *(f32x4*)(rowp + bj * HALF + n * 16) = acc[ai][bj][m][n]; }
    }
};
struct EpiDown {
    static constexpr bool PERM = true;
    bf16_t* D; float* PART;
    DI void operator()(const f32x4 (&acc)[2][2][4][2], const Unit& u, int wr, int wc, int fr, int fq) const {
        const int rl0 = wr * 64 + fr, col0 = u.pn * BM + wc * 32 + 8 * fq;
        if (u.part < 0) {
            bf16_t* base = D + (size_t)(u.pm * BM + rl0) * DM + col0;
#pragma unroll
            for (int ai = 0; ai < 2; ++ai)
#pragma unroll
                for (int m = 0; m < 4; ++m) {
#pragma unroll
                    for (int bj = 0; bj < 2; ++bj) { const f32x4 v0 = acc[ai][bj][m][0], v1 = acc[ai][bj][m][1];
                        u32x4 w; w.x = pk_bf16(v0[0], v0[1]); w.y = pk_bf16(v0[2], v0[3]); w.z = pk_bf16(v1[0], v1[1]); w.w = pk_bf16(v1[2], v1[3]);
                        *(u32x4*)(base + (ai * HALF + m * 16) * DM + bj * HALF) = w; }
                    asm volatile("" ::: "memory");
                }
        } else {
            float* base = PART + ((size_t)u.part * 256 + rl0) * DM + col0;
#pragma unroll
            for (int ai = 0; ai < 2; ++ai)
#pragma unroll
                for (int m = 0; m < 4; ++m) {
#pragma unroll
                    for (int bj = 0; bj < 2; ++bj) { *(f32x4*)(base + (ai * HALF + m * 16) * DM + bj * HALF) = acc[ai][bj][m][0]; *(f32x4*)(base + (ai * HALF + m * 16) * DM + bj * HALF + 4) = acc[ai][bj][m][1]; }
                    asm volatile("" ::: "memory");
                }
        }
    }
};
struct EpiSwiglu {
    static constexpr bool PERM = true;
    bf16_t* H;
    DI void operator()(const f32x4 (&acc)[2][2][4][2], const Unit& u, int wr, int wc, int fr, int fq) const {
        const int row0 = u.pm * BM + wr * 64 + fr, col0 = u.pn * HALF + wc * 32 + 8 * fq;
#pragma unroll
        for (int ai = 0; ai < 2; ++ai)
#pragma unroll
            for (int m = 0; m < 4; ++m) {
                bf16_t* rowp = H + (size_t)(row0 + ai * HALF + m * 16) * DFF + col0;
                float hv[8];
#pragma unroll
                for (int n = 0; n < 2; ++n)
#pragma unroll
                    for (int j = 0; j < 4; ++j) { const float gt = acc[ai][0][m][n][j], up = acc[ai][1][m][n][j]; hv[n * 4 + j] = gt * sigmoidf_(gt) * up; }
                u32x4 w; w.x = pk_bf16(hv[0], hv[1]); w.y = pk_bf16(hv[2], hv[3]); w.z = pk_bf16(hv[4], hv[5]); w.w = pk_bf16(hv[6], hv[7]);
                *(u32x4*)rowp = w;
            }
    }
};
struct EpiInProj {
    static constexpr bool PERM = false;
    bf16_t *Q, *KP, *KS, *VtP, *VtS, *GG; float *LX, *out;
    DI void operator()(const f32x4 (&acc)[2][2][4][2], const Unit& u, int wr, int wc, int fr, int fq) const {
        const int kind = u.pn >> 1;
        const int cbase = (u.pn & 1) * 256 + wc * 32 + 4 * fq;
        const bool samp = (u.pm == MP / 256);
#pragma unroll
        for (int ai = 0; ai < 2; ++ai)
#pragma unroll
            for (int m = 0; m < 4; ++m) {
                const int row = u.pm * BM + ai * HALF + wr * 64 + m * 16 + fr;
                const int rs = row - MP, sb = rs >> 5, st = rs & 31;
#pragma unroll
                for (int bj = 0; bj < 2; ++bj)
#pragma unroll
                    for (int n = 0; n < 2; ++n) {
                        const int col = cbase + bj * HALF + n * 16;
                        const f32x4 v = acc[ai][bj][m][n];
                        if (kind == 0) {
                            const float c1 = 0.125f * LOG2E;
                            u32x2 w; w.x = pk_bf16(v[0] * c1, v[1] * c1); w.y = pk_bf16(v[2] * c1, v[3] * c1);
                            *(u32x2*)(Q + (size_t)row * 512 + col) = w;
                        } else if (kind == 1) {
                            u32x2 w; w.x = pk_bf16(v[0], v[1]); w.y = pk_bf16(v[2], v[3]);
                            const int hd = col >> 7, cl = col & 127;
                            if (!samp) { __builtin_nontemporal_store(v, (f32x4*)(out + OUT_KP + (size_t)row * 512 + col)); *(u32x2*)(KP + ((size_t)((row >> 13) * 4 + hd) * TP + (row & (TP - 1))) * 128 + cl) = w; }
                            else { __builtin_nontemporal_store(v, (f32x4*)(out + OUT_KS + (size_t)rs * 512 + col)); *(u32x2*)(KS + ((size_t)(sb * 4 + hd) * TSP + PAST + st) * 128 + cl) = w; }
                        } else if (kind == 2) {
                            bf16_t* vt;
                            const int hd = col >> 7, dv = col & 127;
                            if (!samp) { __builtin_nontemporal_store(v, (f32x4*)(out + OUT_VP + (size_t)row * 512 + col)); const int t = row & (TP - 1);
                                vt = VtP + (((size_t)((row >> 13) * 4 + hd) * (TP / 64) + (t >> 6)) * 128 + dv) * 64 + vpos(t & 63); }
                            else { __builtin_nontemporal_store(v, (f32x4*)(out + OUT_VS + (size_t)rs * 512 + col)); const int t = PAST + st;
                                vt = VtS + (((size_t)(sb * 4 + hd) * (TSP / 64) + (t >> 6)) * 128 + dv) * 64 + vpos(t & 63); }
                            const unsigned w0 = pk_bf16(v[0], v[1]), w1 = pk_bf16(v[2], v[3]);
                            vt[0] = (bf16_t)(w0 & 0xffffu); vt[64] = (bf16_t)(w0 >> 16); vt[128] = (bf16_t)(w1 & 0xffffu); vt[192] = (bf16_t)(w1 >> 16);
                        } else if (kind == 3) {
                            *(f32x4*)(LX + (size_t)row * 512 + col) = v;
                        } else {
                            u32x2 w; w.x = pk_bf16(gelu_tanh(v[0]), gelu_tanh(v[1])); w.y = pk_bf16(gelu_tanh(v[2]), gelu_tanh(v[3]));
                            *(u32x2*)(GG + (size_t)row * 512 + col) = w;
                        }
                    }
            }
    }
};
}

struct TJob { const float* src; bf16_t* dst; int K, N, ds, mode; };
DI void transpose_tile_wave(LAS float* tile, int lane, const TJob& j, int t) {
    const int ntn = j.N >> 6, k0 = (t / ntn) << 6, n0 = (t % ntn) << 6;
    const float* s = j.src + (size_t)(k0 + (lane >> 4)) * j.N + n0 + (lane & 15) * 4;
    f32x4 v[16];
#pragma unroll
    for (int i = 0; i < 16; ++i) v[i] = *(const f32x4*)(s + (size_t)(i * 4) * j.N);
    LAS float* tp = tile + (lane >> 4) * 65 + (lane & 15) * 4;
#pragma unroll
    for (int i = 0; i < 16; ++i) { tp[i * 4 * 65 + 0] = v[i][0]; tp[i * 4 * 65 + 1] = v[i][1]; tp[i * 4 * 65 + 2] = v[i][2]; tp[i * 4 * 65 + 3] = v[i][3]; }
    asm volatile("s_waitcnt lgkmcnt(0)" ::: "memory");
    const int ks = (lane & 7) * 8;
    const LAS float* rp = tile + ks * 65 + (lane >> 3);
#pragma unroll
    for (int q = 0; q < 8; ++q) {
        float w[8];
#pragma unroll
        for (int e = 0; e < 8; ++e) w[e] = rp[e * 65 + q * 8];
        const int nn = n0 + q * 8 + (lane >> 3);
        u32x4 o; o.x = pk_bf16(w[0], w[1]); o.y = pk_bf16(w[2], w[3]); o.z = pk_bf16(w[4], w[5]); o.w = pk_bf16(w[6], w[7]);
        if (j.mode != 3) { const int R = (j.mode == 0) ? nn : (((nn >> 7) << 8) + (nn & 127) + (j.mode == 2 ? 128 : 0));
            *(u32x4*)(j.dst + (size_t)R * j.ds + k0 + ks) = o; }
        else { bf16_t* d = j.dst + (((size_t)(nn >> 7) * (TSP / 64) + (k0 >> 6)) * 128 + (nn & 127)) * 64 + (ks & 48) + ((ks & 8) >> 1);
               *(u32x2*)d = (u32x2){o.x, o.y}; *(u32x2*)(d + 8) = (u32x2){o.z, o.w}; }
    }
    asm volatile("s_waitcnt lgkmcnt(0)" ::: "memory");
}
constexpr int NWT_FFN1UP = 1408, NWT_ALL = 5136;
DI void weight_tile(const Params& p, LAS float* tile, int lane, int idx) {
    unsigned char* ws = p.ws; TJob j; int t;
    if (idx < 704)       { j = TJob{p.in[I_F1G], (bf16_t*)(ws + WS_WGU1), DM, DFF, DM, 1}; t = idx; }
    else if (idx < 1408) { j = TJob{p.in[I_F1U], (bf16_t*)(ws + WS_WGU1), DM, DFF, DM, 2}; t = idx - 704; }
    else if (idx < 2112) { j = TJob{p.in[I_F1D], (bf16_t*)(ws + WS_WD1), DFF, DM, DFF, 0}; t = idx - 1408; }
    else if (idx < 2752) { j = TJob{p.in[I_WIN], (bf16_t*)(ws + WS_WIN), DM, DIN, DM, 0}; t = idx - 2112; }
    else if (idx < 3008) { j = TJob{p.in[I_WOUT], (bf16_t*)(ws + WS_WOUT), DM, DM, DM, 0}; t = idx - 2752; }
    else if (idx < 3712) { j = TJob{p.in[I_F2G], (bf16_t*)(ws + WS_WGU2), DM, DFF, DM, 1}; t = idx - 3008; }
    else if (idx < 4416) { j = TJob{p.in[I_F2U], (bf16_t*)(ws + WS_WGU2), DM, DFF, DM, 2}; t = idx - 3712; }
    else if (idx < 5120) { j = TJob{p.in[I_F2D], (bf16_t*)(ws + WS_WD2), DFF, DM, DFF, 0}; t = idx - 4416; }
    else if (idx < 5128) { j = TJob{p.in[I_WR], (bf16_t*)(ws + WS_WRT), 512, 64, 512, 0}; t = idx - 5120; }
    else                 { j = TJob{p.in[I_WI], (bf16_t*)(ws + WS_WIT), 512, 64, 512, 0}; t = idx - 5128; }
    transpose_tile_wave(tile, lane, j, t);
}
DI void convert_weights_p0(const Params& p, LAS unsigned char* lds) {
    const int tid = phase_tid(), lane = tid & 63, wv = __builtin_amdgcn_readfirstlane(tid >> 6), gw = blockIdx.x * 8 + wv, nw = gridDim.x * 8;
    LAS float* tile = (LAS float*)(lds + wv * (64 * 65 * 4));
    for (int idx = gw; idx < NWT_FFN1UP; idx += nw) weight_tile(p, tile, lane, idx);
}
constexpr int NCU_V = NBS * 512, NCU_ALL = NCU_V + NBS * (PAST / 16);
DI void cache_unit(const Params& p, LAS float* tile, int lane, int idx) {
    if (idx < NCU_V) {
        const int b = idx >> 9;
        const TJob j{p.in[I_CV] + (size_t)b * PAST * 512, (bf16_t*)(p.ws + WS_VTS) + (size_t)b * 512 * TSP, PAST, 512, TSP, 3};
        transpose_tile_wave(tile, lane, j, idx & 511);
    } else {
        const int u = idx - NCU_V, b = u >> 8, t0 = (u & 255) * 16;
        const float* s = p.in[I_CK] + ((size_t)b * PAST + t0) * 512 + lane * 8;
        bf16_t* d = (bf16_t*)(p.ws + WS_KS) + ((size_t)(b * 4 + (lane >> 4)) * TSP + t0) * 128 + (lane & 15) * 8;
        f32x4 v[32];
#pragma unroll
        for (int r = 0; r < 16; ++r) { v[2 * r] = *(const f32x4*)(s + (size_t)r * 512); v[2 * r + 1] = *(const f32x4*)(s + (size_t)r * 512 + 4); }
#pragma unroll
        for (int r = 0; r < 16; ++r) { u32x4 w; w.x = pk_bf16(v[2 * r][0], v[2 * r][1]); w.y = pk_bf16(v[2 * r][2], v[2 * r][3]); w.z = pk_bf16(v[2 * r + 1][0], v[2 * r + 1][1]); w.w = pk_bf16(v[2 * r + 1][2], v[2 * r + 1][3]);
            *(u32x4*)(d + (size_t)r * 128) = w; }
    }
}
template <int KIND> DI void filler_loop(const Params& p, LAS unsigned char* lds, unsigned* cnt, int first, int total) {
    const int tid = phase_tid(), lane = tid & 63, wv = __builtin_amdgcn_readfirstlane(tid >> 6);
    LAS float* tile = (LAS float*)(lds + wv * (64 * 65 * 4));
    LAS int* slot = (LAS int*)(lds + LDS_CTL);
    const int nchunks = (total - first + 7) >> 3;
    for (;;) {
        if (tid == 0) *slot = (int)atomicAdd(cnt, 1u);
        __syncthreads();
        const int c = *slot;
        __syncthreads();
        if (c >= nchunks) break;
        const int idx = first + c * 8 + wv;
        if (idx < total) { if (KIND == 0) weight_tile(p, tile, lane, idx); else cache_unit(p, tile, lane, idx); }
    }
}

DI const float* xrow(const Params& p, int row) { return row < MP ? p.in[I_XP] + (size_t)row * DM : p.in[I_XS] + (size_t)(row - MP) * DM; }
DI void store_xn(bf16_t* XN, int row, int lane, const f32x4 (&v)[4], float r, const f32x4 (&g)[4]) {
#pragma unroll
    for (int i = 0; i < 4; ++i) { u32x2 w; w.x = pk_bf16(v[i][0] * r * g[i][0], v[i][1] * r * g[i][1]); w.y = pk_bf16(v[i][2] * r * g[i][2], v[i][3] * r * g[i][3]);
        *(u32x2*)(XN + (size_t)row * DM + i * 256 + lane * 4) = w; }
}
DI float sumsq(const f32x4 (&v)[4]) { float s = 0.f;
#pragma unroll
    for (int i = 0; i < 4; ++i) s += v[i][0] * v[i][0] + v[i][1] * v[i][1] + v[i][2] * v[i][2] + v[i][3] * v[i][3];
    return wave_sum(s); }
DI void load_d(const bf16_t* Dh, const float* PART, int nparts, int row, int lane, f32x4 (&d)[4]) {
    if (row < MP) {
#pragma unroll
        for (int i = 0; i < 4; ++i) { const u32x2 w = *(const u32x2*)(Dh + (size_t)row * DM + i * 256 + lane * 4);
            d[i] = (f32x4){__uint_as_float(w.x << 16), __uint_as_float(w.x & 0xffff0000u), __uint_as_float(w.y << 16), __uint_as_float(w.y & 0xffff0000u)}; }
    } else {
#pragma unroll
        for (int i = 0; i < 4; ++i) d[i] = (f32x4){0.f, 0.f, 0.f, 0.f};
#pragma nounroll
        for (int k = 0; k < nparts; ++k)
#pragma unroll
            for (int i = 0; i < 4; ++i) d[i] += *(const f32x4*)(PART + ((size_t)k * 256 + (row - MP)) * DM + i * 256 + lane * 4);
    }
}
template <int MODE> DI void row_pair(const Params& p, int r0, int r1, int lane, const bf16_t* Dh, const float* PART, int nparts, float* Y, bf16_t* XN, const f32x4 (&gp)[4], const f32x4 (&gq)[4], float cs, bool from_x) {
    f32x4 x0[4], x1[4], d0[4], d1[4];
    const float* xp0 = (MODE == 0 || from_x) ? xrow(p, r0) : Y + (size_t)r0 * DM;
    const float* xp1 = (MODE == 0 || from_x) ? xrow(p, r1) : Y + (size_t)r1 * DM;
#pragma unroll
    for (int i = 0; i < 4; ++i) { x0[i] = __builtin_nontemporal_load((const f32x4*)(xp0 + i * 256 + lane * 4)); x1[i] = __builtin_nontemporal_load((const f32x4*)(xp1 + i * 256 + lane * 4)); }
    if (MODE != 0) {
        load_d(Dh, PART, nparts, r0, lane, d0); load_d(Dh, PART, nparts, r1, lane, d1);
        const float rd0 = cs * rsqrtf(sumsq(d0) * (1.0f / DM) + RMS_EPS), rd1 = cs * rsqrtf(sumsq(d1) * (1.0f / DM) + RMS_EPS);
#pragma unroll
        for (int i = 0; i < 4; ++i) { x0[i] = x0[i] + d0[i] * rd0 * gp[i]; x1[i] = x1[i] + d1[i] * rd1 * gp[i];
            __builtin_nontemporal_store(x0[i], (f32x4*)(Y + (size_t)r0 * DM + i * 256 + lane * 4)); __builtin_nontemporal_store(x1[i], (f32x4*)(Y + (size_t)r1 * DM + i * 256 + lane * 4)); }
    }
    if (MODE != 2) {
        const float q0 = rsqrtf(sumsq(x0) * (1.0f / DM) + RMS_EPS), q1 = rsqrtf(sumsq(x1) * (1.0f / DM) + RMS_EPS);
        store_xn(XN, r0, lane, x0, q0, gq); store_xn(XN, r1, lane, x1, q1, gq);
    }
}
template <int MODE> DI void row_phase(const Params& p, const bf16_t* Dh, const float* PART, int nparts, float* Y, bf16_t* XN, const float* gpost, const float* gpre, float cs, bool from_x) {
    const int tid_ = phase_tid(), lane = tid_ & 63, wv = __builtin_amdgcn_readfirstlane(tid_ >> 6), gw = blockIdx.x * 8 + wv, nw = gridDim.x * 8;
    f32x4 gp[4], gq[4];
#pragma unroll
    for (int i = 0; i < 4; ++i) { gp[i] = (MODE != 0) ? *(const f32x4*)(gpost + i * 256 + lane * 4) : (f32x4){0.f, 0.f, 0.f, 0.f}; gq[i] = (MODE != 2) ? *(const f32x4*)(gpre + i * 256 + lane * 4) : (f32x4){0.f, 0.f, 0.f, 0.f}; }
#pragma nounroll
    for (int pr = gw; pr < MP / 2; pr += nw) row_pair<MODE>(p, 2 * pr, 2 * pr + 1, lane, Dh, PART, nparts, Y, XN, gp, gq, cs, from_x);
    if (wv == 0) {
#pragma nounroll
        for (int r = MP + blockIdx.x; r < MT; r += gridDim.x) row_pair<MODE>(p, r, r, lane, Dh, PART, nparts, Y, XN, gp, gq, cs, from_x);
    }
}

constexpr int LRS = 68;
DI int crow16(int reg, int hh) { return (reg & 3) + 8 * (reg >> 2) + 4 * hh; }
struct LruConst { float cw0, cw1, cw2, cw3, cb, sp8[2], brv[2], biv[2]; bf16x8 fwr[2][4], fwi[2][4]; };
DI void lru_load_const(const Params& p, LruConst& k) {
    const int tid = phase_tid(), w = __builtin_amdgcn_readfirstlane(tid >> 6), lane = tid & 63, cc = lane & 31, hh = lane >> 5, ch = w * 64 + lane;
    k.cw0 = p.in[I_CW][ch]; k.cw1 = p.in[I_CW][512 + ch]; k.cw2 = p.in[I_CW][1024 + ch]; k.cw3 = p.in[I_CW][1536 + ch]; k.cb = p.in[I_CB][ch];
#pragma unroll
    for (int q = 0; q < 2; ++q) { const int ce = w * 64 + q * 32 + cc; k.sp8[q] = 8.0f * log1pf(__expf(-p.in[I_LAM][ce])); k.brv[q] = p.in[I_BR][ce]; k.biv[q] = p.in[I_BI][ce]; }
    const bf16_t* WRT = (const bf16_t*)(p.ws + WS_WRT); const bf16_t* WIT = (const bf16_t*)(p.ws + WS_WIT);
    const size_t wo = (size_t)cc * 512 + w * 64 + hh * 8;
#pragma unroll
    for (int q = 0; q < 2; ++q)
#pragma unroll
        for (int ks = 0; ks < 4; ++ks) { k.fwr[q][ks] = *(const bf16x8*)(WRT + wo + (size_t)q * 32 * 512 + ks * 16); k.fwi[q][ks] = *(const bf16x8*)(WIT + wo + (size_t)q * 32 * 512 + ks * 16); }
}
DI void lru_local_item(const Params& p, LAS unsigned char* lds, int item, const LruConst& k) {
    const int tid = phase_tid(), w = __builtin_amdgcn_readfirstlane(tid >> 6), lane = tid & 63, cc = lane & 31, hh = lane >> 5;
    int s, c, row0, nhalf; const bool samp = item >= NBP * 128;
    if (!samp) { s = item >> 7; c = item & 127; row0 = s * TP + c * 64; nhalf = 2; } else { s = NBP + (item - NBP * 128); c = 0; row0 = MP + (s - NBP) * TSQ; nhalf = 1; }
    const float* LX = (const float*)(p.ws + WS_LX);
    bf16_t* PP = (bf16_t*)(p.ws + WS_PP); bf16_t* HL = (bf16_t*)(p.ws + WS_HL);
    LAS float* xs = (LAS float*)(lds + w * (2 * 32 * LRS * 4)); LAS float* as = xs + 32 * LRS;
    const int ch = w * 64 + lane;
    const float cw0 = k.cw0, cw1 = k.cw1, cw2 = k.cw2, cw3 = k.cw3, cb = k.cb;
    float xm3, xm2, xm1;
    if (samp) { const float* sc = p.in[I_SC] + (size_t)(s - NBP) * 3 * 512 + ch; xm3 = sc[0]; xm2 = sc[512]; xm1 = sc[1024]; }
    else if (c == 0) { xm3 = 0.f; xm2 = 0.f; xm1 = 0.f; }
    else { const float* lp = LX + (size_t)(row0 - 3) * 512 + ch; xm3 = lp[0]; xm2 = lp[512]; xm1 = lp[1024]; }
    float Pc = 1.0f, hc = 0.0f;
    LAS float* xe = xs + 4 * hh * LRS + cc;
    LAS float* ae = as + 4 * hh * LRS + cc;
    float xin[2][32];
#pragma unroll
    for (int hf = 0; hf < 2; ++hf)
#pragma unroll
        for (int t = 0; t < 32; ++t) xin[hf][t] = (hf < nhalf) ? LX[(size_t)(row0 + hf * 32 + t) * 512 + ch] : 0.f;
#pragma unroll
    for (int half = 0; half < 2; ++half) {
        if (half >= nhalf) break;
        const int rbase = row0 + half * 32;
#pragma unroll
        for (int t = 0; t < 32; ++t) { const float xv = xin[half][t]; const float y = cb + cw0 * xm3 + cw1 * xm2 + cw2 * xm1 + cw3 * xv; xs[t * LRS + lane] = y; xm3 = xm2; xm2 = xm1; xm1 = xv; }
        asm volatile("s_waitcnt lgkmcnt(0)" ::: "memory");
        bf16x8 af[4];
#pragma unroll
        for (int ks = 0; ks < 4; ++ks) {
            const f32x4 lo = *(const LAS f32x4*)(xs + cc * LRS + ks * 16 + hh * 8), hi = *(const LAS f32x4*)(xs + cc * LRS + ks * 16 + hh * 8 + 4);
            u32x4 pa; pa.x = pk_bf16(lo[0], lo[1]); pa.y = pk_bf16(lo[2], lo[3]); pa.z = pk_bf16(hi[0], hi[1]); pa.w = pk_bf16(hi[2], hi[3]);
            af[ks] = __builtin_bit_cast(bf16x8, pa);
        }
#pragma unroll
        for (int q = 0; q < 2; ++q) {
            const float sp8 = k.sp8[q], brv = k.brv[q];
            f32x16 acc;
#pragma unroll
            for (int e = 0; e < 16; ++e) acc[e] = 0.f;
#pragma unroll
            for (int ks = 0; ks < 4; ++ks) acc = __builtin_amdgcn_mfma_f32_32x32x16_bf16(af[ks], k.fwr[q][ks], acc, 0, 0, 0);
#pragma unroll
            for (int e = 0; e < 16; ++e) { const float rg = sigmoidf_(acc[e] + brv); ae[((e & 3) + 8 * (e >> 2)) * LRS + q * 32] = __expf(-rg * sp8); }
            asm volatile("" ::: "memory");
        }
#pragma unroll
        for (int q = 0; q < 2; ++q) {
            const float biv = k.biv[q];
            f32x16 acc;
#pragma unroll
            for (int e = 0; e < 16; ++e) acc[e] = 0.f;
#pragma unroll
            for (int ks = 0; ks < 4; ++ks) acc = __builtin_amdgcn_mfma_f32_32x32x16_bf16(af[ks], k.fwi[q][ks], acc, 0, 0, 0);
#pragma unroll
            for (int e = 0; e < 16; ++e) { const int ix = ((e & 3) + 8 * (e >> 2)) * LRS + q * 32; const float ig = sigmoidf_(acc[e] + biv), a = ae[ix], xc = xe[ix];
                xe[ix] = sqrtf(fmaxf(1.0f - a * a, 0.0f)) * ig * xc; }
            asm volatile("" ::: "memory");
        }
        asm volatile("s_waitcnt lgkmcnt(0)" ::: "memory");
#pragma unroll 8
        for (int t = 0; t < 32; ++t) { const float a = as[t * LRS + lane], bx = xs[t * LRS + lane]; Pc *= a; hc = a * hc + bx;
            const size_t o = (size_t)(rbase + t) * 512 + ch; PP[o] = (bf16_t)(pk_bf16(Pc, 0.f) & 0xffffu); HL[o] = (bf16_t)(pk_bf16(hc, 0.f) & 0xffffu); }
        asm volatile("s_waitcnt lgkmcnt(0)" ::: "memory");
    }
    float* AP = (float*)(p.ws + WS_AP); float* HE = (float*)(p.ws + WS_HE);
    AP[(size_t)(s * 128 + c) * 512 + ch] = Pc; HE[(size_t)(s * 128 + c) * 512 + ch] = hc;
}

DI void lru_carry_scan(const Params& p, int s) {
    const int ch = phase_tid();
    const float* AP = (const float*)(p.ws + WS_AP) + (size_t)s * 128 * 512 + ch; const float* HE = (const float*)(p.ws + WS_HE) + (size_t)s * 128 * 512 + ch;
    float* CAR = (float*)(p.ws + WS_CAR) + (size_t)s * 128 * 512 + ch;
    float carry = 0.0f;
    for (int c0 = 0; c0 < 128; c0 += 16) {
        float a[16], h[16];
#pragma unroll
        for (int j = 0; j < 16; ++j) { a[j] = AP[(size_t)(c0 + j) * 512]; h[j] = HE[(size_t)(c0 + j) * 512]; }
#pragma unroll
        for (int j = 0; j < 16; ++j) { CAR[(size_t)(c0 + j) * 512] = carry; carry = a[j] * carry + h[j]; }
    }
    p.out[OUT_LHP + (size_t)s * 512 + ch] = carry;
    __threadfence();
    __syncthreads();
    if (threadIdx.x == 0) __hip_atomic_fetch_add((unsigned*)(p.ws + WS_CNT) + 1, 1u, __ATOMIC_RELEASE, __HIP_MEMORY_SCOPE_AGENT);
}
DI void lru_final_item(const Params& p, int item) {
    const int ch = phase_tid();
    int s, c, row0, ntok; const bool samp = item >= NBP * 128;
    if (!samp) { s = item >> 7; c = item & 127; row0 = s * TP + c * 64; ntok = 64; } else { s = NBP + (item - NBP * 128); c = 0; row0 = MP + (s - NBP) * TSQ; ntok = 32; }
    const bf16_t* PP = (const bf16_t*)(p.ws + WS_PP); const bf16_t* HL = (const bf16_t*)(p.ws + WS_HL); const bf16_t* GG = (const bf16_t*)(p.ws + WS_GG);
    bf16_t* MIX = (bf16_t*)(p.ws + WS_C);
    float carry;
    if (samp) carry = p.in[I_SH][(size_t)(s - NBP) * 512 + ch];
    else {
        if (threadIdx.x == 0) { const unsigned* fl = (const unsigned*)(p.ws + WS_CNT) + 1;
            while (__hip_atomic_load(fl, __ATOMIC_RELAXED, __HIP_MEMORY_SCOPE_AGENT) < (unsigned)NBP) __builtin_amdgcn_s_sleep(8);
            __builtin_amdgcn_fence(__ATOMIC_ACQUIRE, "agent"); }
        __syncthreads();
        carry = __hip_atomic_load((const float*)(p.ws + WS_CAR) + (size_t)(s * 128 + c) * 512 + ch, __ATOMIC_RELAXED, __HIP_MEMORY_SCOPE_AGENT);
    }
#pragma unroll 32
    for (int t = 0; t < ntok; ++t) { const size_t o = (size_t)(row0 + t) * 512 + ch; const float hv = bf2f(HL[o]) + bf2f(PP[o]) * carry;
        MIX[(size_t)(row0 + t) * DM + 512 + ch] = (bf16_t)(pk_bf16(hv * bf2f(GG[o]), 0.f) & 0xffffu); }
    if (samp || c == 127) {
        const float* LX = (const float*)(p.ws + WS_LX); const int rl = row0 + ntok - 3;
        if (!samp) {
#pragma unroll
            for (int j = 0; j < 3; ++j) p.out[OUT_CVP + (size_t)(s * 3 + j) * 512 + ch] = LX[(size_t)(rl + j) * 512 + ch]; }
        else { const int b = s - NBP; const size_t o = (size_t)(s * 128) * 512 + ch;
            p.out[OUT_LHS + (size_t)b * 512 + ch] = ((const float*)(p.ws + WS_HE))[o] + ((const float*)(p.ws + WS_AP))[o] * carry;
#pragma unroll
            for (int j = 0; j < 3; ++j) p.out[OUT_CVS + (size_t)(b * 3 + j) * 512 + ch] = LX[(size_t)(rl + j) * 512 + ch]; }
    }
}

DI void knorm_items(const Params& p) {
    if (blockIdx.x < NBS && gridDim.x > 2 * NBS) return;
    const int skip = (gridDim.x > 2 * NBS) ? NBS : 0;
    const int tid_ = phase_tid(), lane = tid_ & 63, gw = (blockIdx.x - skip) * 8 + (tid_ >> 6), nw = (gridDim.x - skip) * 8;
    const int NP = NBP * 4 * 128, NS = NBS * 4 * (TSP / 64);
    for (int it = gw; it < NP + NS; it += nw) {
        const bf16_t* kt; float* dst; bool valid = true;
        if (it < NP) { const int bh = it >> 7, t = it & 127; kt = (const bf16_t*)(p.ws + WS_KP) + ((size_t)bh * TP + t * 64) * 128; dst = (float*)(p.ws + WS_KNP) + (size_t)bh * 256 + t; }
        else { const int j = it - NP, bh = j / (TSP / 64), t = j % (TSP / 64); kt = (const bf16_t*)(p.ws + WS_KS) + ((size_t)bh * TSP + t * 64) * 128; dst = (float*)(p.ws + WS_KNS) + (size_t)bh * 256 + t;
               valid = (t * 64 + lane) < (PAST + TSQ); }
        float n0 = 0.f, n1 = 0.f;
#pragma unroll
        for (int i = 0; i < 16; ++i) { const u32x4 w = *(const u32x4*)(kt + (size_t)lane * 128 + i * 8); float s = 0.f;
#pragma unroll
            for (int j = 0; j < 4; ++j) { const float lo = __uint_as_float(w[j] << 16), hi = __uint_as_float(w[j] & 0xffff0000u); s += lo * lo + hi * hi; }
            if (i < 8) n0 += s; else n1 += s; }
        if (!valid) { n0 = 0.f; n1 = 0.f; }
#pragma unroll
        for (int o = 32; o >= 1; o >>= 1) { n0 = fmaxf(n0, __shfl_xor(n0, o)); n1 = fmaxf(n1, __shfl_xor(n1, o)); }
        if (lane == 0) { dst[0] = n0; dst[128] = n1; }
    }
}

constexpr int ATT_KROW = 272, ATT_VROW = 144, ATT_VOFF = 64 * ATT_KROW, ATT_BUF = ATT_VOFF + 128 * ATT_VROW;
constexpr int ATT_PMT = 2 * ATT_BUF;
constexpr int ATT_PUB = ATT_PMT + 1024;
constexpr float ATT_SKIP = 40.0f;
DI void att_compute(const LAS unsigned char* Kl, int t, int nkb, int qpos0, int cq, int hh, int c, float sl2, const bf16x8 (&qf)[4], f32x16 (&O)[4], float& mrun, float& lrun) {
    const int kb_lim = nkb - 2 * t;
    if (kb_lim <= 0) return;
    const LAS unsigned char* kp = Kl + cq * ATT_KROW + (c * 64 + hh * 8) * 2;
    const LAS unsigned char* vp = Kl + ATT_VOFF + cq * ATT_VROW + hh * 16;
    bf16x8 ka[8];
#pragma unroll
    for (int ks = 0; ks < 4; ++ks) { ka[2 * ks] = *(const LAS bf16x8*)(kp + ks * 32); ka[2 * ks + 1] = *(const LAS bf16x8*)(kp + 32 * ATT_KROW + ks * 32); }
    __builtin_amdgcn_sched_barrier(0);
    f32x16 S0, S1;
#pragma unroll
    for (int e = 0; e < 16; ++e) { S0[e] = 0.f; S1[e] = 0.f; }
#pragma unroll
    for (int ks = 0; ks < 4; ++ks) {
        S0 = __builtin_amdgcn_mfma_f32_32x32x16_bf16(ka[2 * ks], qf[ks], S0, 0, 0, 0);
        S1 = __builtin_amdgcn_mfma_f32_32x32x16_bf16(ka[2 * ks + 1], qf[ks], S1, 0, 0, 0);
    }
    __builtin_amdgcn_sched_barrier(0);
    bf16x8 va[8];
#pragma unroll
    for (int g = 0; g < 2; ++g)
#pragma unroll
        for (int d = 0; d < 4; ++d) va[g * 4 + d] = *(const LAS bf16x8*)(vp + d * 32 * ATT_VROW + g * 32);
    __builtin_amdgcn_sched_barrier(0);
    float rel0 = (float)(qpos0 + cq - (t * 64 + 4 * hh));
    asm volatile("" : "+v"(rel0));
    const float rel1 = rel0 - 32.0f;
    const bool two = kb_lim > 1;
    float mt = -1e30f;
#pragma unroll
    for (int e = 0; e < 16; ++e) { const float off = (float)((e & 3) + 8 * (e >> 2));
        S0[e] = S0[e] - sl2 * fabsf(rel0 - off);
        S1[e] = two ? (S1[e] - sl2 * fabsf(rel1 - off)) : -1e30f;
        mt = fmaxf(mt, fmaxf(S0[e], S1[e])); }
    mt = fmaxf(mt, __shfl_xor(mt, 32));
    if (__any(mt > mrun)) {
        const float mnew = fmaxf(mrun, mt), alpha = __builtin_amdgcn_exp2f(mrun - mnew);
        mrun = mnew; lrun *= alpha;
#pragma unroll
        for (int d = 0; d < 4; ++d)
#pragma unroll
            for (int e = 0; e < 16; ++e) O[d][e] *= alpha;
    }
    float ps = 0.f;
#pragma unroll
    for (int e = 0; e < 16; ++e) { S0[e] = __builtin_amdgcn_exp2f(S0[e] - mrun); S1[e] = __builtin_amdgcn_exp2f(S1[e] - mrun); ps += S0[e] + S1[e]; }
    lrun += ps;
    u32x4 pf[4];
#pragma unroll
    for (int s = 0; s < 2; ++s) {
        pf[s].x = pk_bf16(S0[8 * s + 0], S0[8 * s + 1]); pf[s].y = pk_bf16(S0[8 * s + 2], S0[8 * s + 3]); pf[s].z = pk_bf16(S0[8 * s + 4], S0[8 * s + 5]); pf[s].w = pk_bf16(S0[8 * s + 6], S0[8 * s + 7]);
        pf[2 + s].x = pk_bf16(S1[8 * s + 0], S1[8 * s + 1]); pf[2 + s].y = pk_bf16(S1[8 * s + 2], S1[8 * s + 3]); pf[2 + s].z = pk_bf16(S1[8 * s + 4], S1[8 * s + 5]); pf[2 + s].w = pk_bf16(S1[8 * s + 6], S1[8 * s + 7]);
    }
    __builtin_amdgcn_sched_barrier(0);
    bf16x8 vb[8];
#pragma unroll
    for (int g = 0; g < 2; ++g)
#pragma unroll
        for (int d = 0; d < 4; ++d) vb[g * 4 + d] = *(const LAS bf16x8*)(vp + d * 32 * ATT_VROW + (2 + g) * 32);
    __builtin_amdgcn_sched_barrier(0);
#pragma unroll
    for (int g = 0; g < 2; ++g)
#pragma unroll
        for (int d = 0; d < 4; ++d) O[d] = __builtin_amdgcn_mfma_f32_32x32x16_bf16(va[g * 4 + d], __builtin_bit_cast(bf16x8, pf[g]), O[d], 0, 0, 0);
    __builtin_amdgcn_sched_barrier(0);
#pragma unroll
    for (int g = 0; g < 2; ++g)
#pragma unroll
        for (int d = 0; d < 4; ++d) O[d] = __builtin_amdgcn_mfma_f32_32x32x16_bf16(vb[g * 4 + d], __builtin_bit_cast(bf16x8, pf[2 + g]), O[d], 0, 0, 0);
    __builtin_amdgcn_sched_barrier(0);
}
DI void attn_item(const Params& p, LAS unsigned char* lds, int kind, int b, int h, int qb, float lam, unsigned* qcnt, LAS int* slot) {
    const int tid = phase_tid(), wave = __builtin_amdgcn_readfirstlane(tid >> 6), lane = tid & 63, c = wave >> 2, rg = wave & 3, cq = lane & 31, hh = lane >> 5;
    const bf16_t* Qg = (const bf16_t*)(p.ws + WS_Q);
    const bf16_t *Kb, *Vb; const float* KN; int ntiles, nkb, rowbase, qpos0, qmin;
    if (kind == 0) { Kb = (const bf16_t*)(p.ws + WS_KP) + (size_t)(b * 4 + h) * TP * 128; Vb = (const bf16_t*)(p.ws + WS_VTP) + (size_t)(b * 4 + h) * TP * 128; KN = (const float*)(p.ws + WS_KNP) + (size_t)(b * 4 + h) * 256;
        ntiles = 2 * qb + 2; nkb = (2 * qb + (rg >> 1) + 1) * 2; rowbase = b * TP + qb * 128 + rg * 32; qpos0 = qb * 128 + rg * 32; qmin = qb * 128; }
    else { Kb = (const bf16_t*)(p.ws + WS_KS) + (size_t)(b * 4 + h) * TSP * 128; Vb = (const bf16_t*)(p.ws + WS_VTS) + (size_t)(b * 4 + h) * TSP * 128; KN = (const float*)(p.ws + WS_KNS) + (size_t)(b * 4 + h) * 256;
        ntiles = TSP / 64; nkb = (rg == 0) ? (PAST + TSQ) / 32 : 0; rowbase = MP + b * TSQ; qpos0 = PAST; qmin = PAST; }
    const bool active = nkb > 0;
    const bf16_t* kg = Kb + (size_t)tid * 8;
    const bf16_t* vg = Vb + (size_t)tid * 8;
    const int kl0 = (tid >> 4) * ATT_KROW + (tid & 15) * 16, vl0 = ATT_VOFF + (tid >> 3) * ATT_VROW + (tid & 7) * 16;
    u32x4 rA0, rA1, rA2, rA3, rB0, rB1, rB2, rB3;
#define ATT_LOAD(t, r0, r1, r2, r3) do { const bf16_t* _k = kg + (size_t)(t) * 8192; r0 = *(const u32x4*)_k; r1 = *(const u32x4*)(_k + 4096); const bf16_t* _v = vg + (size_t)(t) * 8192; r2 = *(const u32x4*)_v; r3 = *(const u32x4*)(_v + 4096); } while (0)
#define ATT_WRITE(buf, r0, r1, r2, r3) do { LAS unsigned char* _b = lds + (buf) * ATT_BUF; *(LAS u32x4*)(_b + kl0) = r0; *(LAS u32x4*)(_b + kl0 + 32 * ATT_KROW) = r1; \
        *(LAS u32x4*)(_b + vl0) = r2; *(LAS u32x4*)(_b + vl0 + 64 * ATT_VROW) = r3; } while (0)
    ATT_LOAD(ntiles - 1, rA0, rA1, rA2, rA3);
    ATT_LOAD(ntiles - 2, rB0, rB1, rB2, rB3);
    const float kn0 = (rg == 0 && 2 * lane < ntiles) ? KN[c * 128 + 2 * lane] : 0.f, kn1 = (rg == 0 && 2 * lane + 1 < ntiles) ? KN[c * 128 + 2 * lane + 1] : 0.f;
    bf16x8 qf[4];
#pragma unroll
    for (int ks = 0; ks < 4; ++ks) qf[ks] = *(const bf16x8*)(Qg + (size_t)(rowbase + cq) * 512 + h * 128 + c * 64 + ks * 16 + hh * 8);
    const float sl2 = exp2f(-2.0f * (float)(h + 1)) * LOG2E;
    LAS float* pmt = (LAS float*)(lds + ATT_PMT); LAS float* pub = (LAS float*)(lds + ATT_PUB);
    {
        float qs = 0.f;
#pragma unroll
        for (int ks = 0; ks < 4; ++ks)
#pragma unroll
            for (int j = 0; j < 8; ++j) { const float v = __uint_as_float(((unsigned)(unsigned short)qf[ks][j]) << 16); qs += v * v; }
        qs += __shfl_xor(qs, 32);
#pragma unroll
        for (int o = 16; o >= 1; o >>= 1) qs = fmaxf(qs, __shfl_xor(qs, o));
        if (lane == 0) pub[wave] = active ? qs : 0.f;
        if (rg == 0) {
            const float k0 = kn0; float k1 = fmaxf(kn0, kn1);
            float run = k1;
#pragma unroll
            for (int o = 1; o < 64; o <<= 1) { const float up = __shfl_up(run, o); if (lane >= o) run = fmaxf(run, up); }
            const float prev = __shfl_up(run, 1);
            pmt[c * 128 + 2 * lane] = fmaxf(k0, lane > 0 ? prev : 0.f); pmt[c * 128 + 2 * lane + 1] = run;
        }
    }
    f32x16 O[4];
#pragma unroll
    for (int d = 0; d < 4; ++d)
#pragma unroll
        for (int e = 0; e < 16; ++e) O[d][e] = 0.f;
    float mrun = -1e30f, lrun = 0.f;
    ATT_WRITE(0, rA0, rA1, rA2, rA3);
    __syncthreads();
    const float qn0 = sqrtf(fmaxf(fmaxf(pub[0], pub[1]), fmaxf(pub[2], pub[3]))), qn1 = sqrtf(fmaxf(fmaxf(pub[4], pub[5]), fmaxf(pub[6], pub[7])));
    float mlb0 = 0.f, mlb1 = 0.f;
    int NT = ntiles;
#define ATT_STEP(n, N0, N1, N2, N3, O0, O1, O2, O3) do { \
        if ((n) + 2 < NT) { \
            bool drop = false; \
            if ((n) >= 2) { const int tn = ntiles - 3 - (n); const float dmin = sl2 * (float)(qmin - (tn * 64 + 63)); \
                const float ub0 = qn0 * sqrtf(pmt[tn]) - dmin, ub1 = qn1 * sqrtf(pmt[128 + tn]) - dmin; \
                drop = (ub0 < mlb0 - ATT_SKIP) && (ub1 < mlb1 - ATT_SKIP); } \
            if (drop) NT = (n) + 2; else ATT_LOAD(ntiles - 3 - (n), N0, N1, N2, N3); \
        } \
        att_compute(lds + ((n) & 1) * ATT_BUF, ntiles - 1 - (n), nkb, qpos0, cq, hh, c, sl2, qf, O, mrun, lrun); \
        if ((n) == 1) { float mm = active ? mrun : 1e30f; \
            _Pragma("unroll") for (int o = 16; o >= 1; o >>= 1) mm = fminf(mm, __shfl_xor(mm, o)); \
            if (lane == 0) pub[8 + wave] = mm; } \
        if ((n) + 1 < NT) ATT_WRITE(((n) + 1) & 1, O0, O1, O2, O3); \
        __syncthreads(); \
        if ((n) == 1) { mlb0 = fminf(fminf(pub[8], pub[9]), fminf(pub[10], pub[11])); mlb1 = fminf(fminf(pub[12], pub[13]), fminf(pub[14], pub[15])); } \
    } while (0)
    for (int n = 0; n < NT; n += 2) {
        ATT_STEP(n, rA0, rA1, rA2, rA3, rB0, rB1, rB2, rB3);
        if (n + 1 >= NT) break;
        ATT_STEP(n + 1, rB0, rB1, rB2, rB3, rA0, rA1, rA2, rA3);
    }
#undef ATT_STEP
#undef ATT_LOAD
#undef ATT_WRITE
    int nxt_ticket = 0;
    if (tid == 0) nxt_ticket = (int)atomicAdd(qcnt, 1u);
    const float lt = lrun + __shfl_xor(lrun, 32);
    const float inv = active ? 1.0f / lt : 0.0f;
    LAS float* ex = (LAS float*)lds + ((rg * 128 + 4 * hh) * 32 + cq);
    if (c == 1) {
#pragma unroll
        for (int d = 0; d < 4; ++d)
#pragma unroll
            for (int e = 0; e < 16; ++e) ex[(d * 32 + (e & 3) + 8 * (e >> 2)) * 32] = O[d][e] * inv;
    }
    LAS float* sgl = (LAS float*)(lds + 65536 + 4 * (32 * 272));
    if (tid < 128) sgl[tid] = p.in[I_SUBG][tid];
    __syncthreads();
    if (c == 0) {
        float ss = 0.f;
#pragma unroll
        for (int d = 0; d < 4; ++d)
#pragma unroll
            for (int e = 0; e < 16; ++e) { const float o = O[d][e] * inv - lam * ex[(d * 32 + (e & 3) + 8 * (e >> 2)) * 32]; O[d][e] = o; ss += o * o; }
        ss += __shfl_xor(ss, 32);
        const float rn = rsqrtf(ss * (1.0f / 128.0f) + RMS_EPS) * 0.8f;
        LAS unsigned char* stg = lds + 65536 + rg * (32 * 272);
        LAS unsigned char* sb = stg + cq * 272 + 8 * hh; const LAS float* sgb = sgl + 4 * hh;
#pragma unroll
        for (int d = 0; d < 4; ++d)
#pragma unroll
            for (int e = 0; e < 16; e += 2) { const int dc = d * 32 + (e & 3) + 8 * (e >> 2);
                *(LAS unsigned*)(sb + dc * 2) = pk_bf16(O[d][e] * rn * sgb[dc], O[d][e + 1] * rn * sgb[dc + 1]); }
        asm volatile("s_waitcnt lgkmcnt(0)" ::: "memory");
        if (active) {
            bf16_t* MIX = (bf16_t*)(p.ws + WS_C);
#pragma unroll
            for (int it = 0; it < 8; ++it) { const int row = it * 4 + (lane >> 4), seg = lane & 15;
                const u32x4 wv = *(const LAS u32x4*)(stg + row * 272 + seg * 16);
                *(u32x4*)(MIX + (size_t)(rowbase + row) * DM + h * 128 + seg * 8) = wv; }
        }
    }
    if (tid == 0) *slot = nxt_ticket;
    __syncthreads();
}

#define XB_TMO      128
#define XB_XCNT(j)  (256  + 64 * (j))
#define XB_XSUB(j)  (1280 + 64 * (j))
#define XB_XGEN(j)  (2304 + 64 * (j))
#define XB_TOP      3328
#define XB_TOPGEN   3392
#define XCD_BAR_WORDS 3456
#define XB_SPIN_CAP (1u << 20)
DI unsigned xb_ld(unsigned* p)              { return __hip_atomic_load(p, __ATOMIC_RELAXED, __HIP_MEMORY_SCOPE_AGENT); }
DI unsigned xb_add(unsigned* p, unsigned v) { return __hip_atomic_fetch_add(p, v, __ATOMIC_RELAXED, __HIP_MEMORY_SCOPE_AGENT); }
DI unsigned xb_xcc_id() { return (unsigned)__builtin_amdgcn_s_getreg((3 << 11) | 20) & 0xFu; }
#define XB_SPIN(cond, bar) do { unsigned _sp = 0; while (cond) { __builtin_amdgcn_s_sleep(1); \
    if ((++_sp & 255u) == 0u) { if (xb_ld(&(bar)[XB_TMO])) break; if (_sp > XB_SPIN_CAP) { atomicAdd(&(bar)[XB_TMO], 1u); break; } } } } while (0)
struct XcdBarrier { unsigned* bar; unsigned x; volatile LAS unsigned* st; };
DI XcdBarrier xcd_barrier_post(unsigned* bar, volatile LAS unsigned* st) {
    XcdBarrier b; b.bar = bar; b.x = xb_xcc_id(); b.st = st;
    if (threadIdx.x == 0) (void)xb_add(&bar[XB_XCNT(b.x)], 1u);
    return b;
}
DI void xcd_barrier_complete(unsigned* bar, unsigned x, unsigned& nloc, unsigned& nx) {
    const unsigned G = gridDim.x * gridDim.y * gridDim.z;
    unsigned sum, cnt, mine, sp = 0u;
    for (;;) {
        sum = 0u; cnt = 0u; mine = 0u;
#pragma unroll
        for (unsigned j = 0; j < 16; ++j) { const unsigned c = xb_ld(&bar[XB_XCNT(j)]); sum += c; cnt += (c > 0u) ? 1u : 0u; mine = (j == x) ? c : mine; }
        if (sum == G) break;
        __builtin_amdgcn_s_sleep(1);
        if ((++sp & 255u) == 0u) { if (xb_ld(&bar[XB_TMO])) break; if (sp > XB_SPIN_CAP) { atomicAdd(&bar[XB_TMO], 1u); break; } }
    }
    nloc = mine > 0u ? mine : 1u; nx = cnt > 0u ? cnt : 1u;
}
DI void xcd_barrier(const XcdBarrier& b) {
    asm volatile("s_waitcnt vmcnt(0)" ::: "memory");
    __syncthreads();
    if (threadIdx.x == 0) {
        unsigned* bar = b.bar;
        __builtin_amdgcn_s_waitcnt(0);
        unsigned nloc = b.st[0], nx = b.st[1];
        if (nloc == 0u) { xcd_barrier_complete(bar, b.x, nloc, nx); b.st[0] = nloc; b.st[1] = nx; }
        const unsigned old = xb_add(&bar[XB_XSUB(b.x)], 1u);
        const unsigned gen = old / nloc;
        if (old + 1u == (gen + 1u) * nloc) {
            __builtin_amdgcn_fence(__ATOMIC_RELEASE, "agent");
            asm volatile("s_waitcnt vmcnt(0)" ::: "memory");
            const unsigned og = xb_add(&bar[XB_TOP], 1u);
            const unsigned tg = og / nx;
            if (og + 1u == (tg + 1u) * nx) xb_add(&bar[XB_TOPGEN], 1u);
            else XB_SPIN(xb_ld(&bar[XB_TOPGEN]) == tg, bar);
            __builtin_amdgcn_fence(__ATOMIC_ACQUIRE, "agent");
            xb_add(&bar[XB_XGEN(b.x)], 1u);
            asm volatile("s_waitcnt vmcnt(0)" ::: "memory");
        } else {
            XB_SPIN(xb_ld(&bar[XB_XGEN(b.x)]) == gen, bar);
            __builtin_amdgcn_fence(__ATOMIC_ACQUIRE, "agent");
            asm volatile("s_waitcnt vmcnt(0)" ::: "memory");
        }
    }
    __syncthreads();
}

__global__ void __launch_bounds__(NTHREADS, 2) fwd_megakernel(Params p) {
    extern __shared__ __attribute__((aligned(16))) unsigned char lds_raw[];
    LAS unsigned char* lds = (LAS unsigned char*)lds_raw;
    volatile LAS unsigned* xst = (volatile LAS unsigned*)(lds + LDS_CTL + 16);
    if (threadIdx.x < 2) xst[threadIdx.x] = 0u;
    __syncthreads();
    const XcdBarrier xbar = xcd_barrier_post((unsigned*)(p.ws + WS_BAR), xst);
    const int lo = p.ph_lo, hi = p.ph_hi;
    const int G = gridDim.x, bid = blockIdx.x;
    unsigned char* ws = p.ws;
    bf16_t* XN = (bf16_t*)(ws + WS_C); bf16_t* Hb = (bf16_t*)(ws + WS_A); bf16_t* Dh = (bf16_t*)(ws + WS_B); float* PART = (float*)(ws + WS_B + SZ_XN);    float* Y = p.out + OUT_Y;
#define IN(k) (lo <= (k) && (k) < hi)
#define SEAM(k) do { asm volatile("" ::: "memory"); if ((k) + 1 < hi) xcd_barrier(xbar); asm volatile("" ::: "memory"); } while (0)

    if (IN(0)) {
        convert_weights_p0(p, lds);
        if (bid == 0 && threadIdx.x == 0) __hip_atomic_store((unsigned*)(ws + WS_CNT) + 2, 0u, __ATOMIC_RELAXED, __HIP_MEMORY_SCOPE_AGENT);
        row_phase<0>(p, nullptr, nullptr, 0, nullptr, XN, nullptr, p.in[I_G1A], 0.f, true);
        SEAM(0);
    }
    if (IN(1)) {
        pg8::Gemm g{XN, (const bf16_t*)(ws + WS_WGU1), MT, 2 * DFF, DM}; pg8::StaticOrder S; S.init(MT, 2 * DFF, DM, G, bid);
        pg8::EpiSwiglu E{Hb};
        pg8::gemm_phase<pg8::EpiSwiglu, pg8::StaticOrder>(lds, g, S, E);
        filler_loop<0>(p, lds, (unsigned*)(ws + WS_CNT) + 2, NWT_FFN1UP, NWT_ALL);
        SEAM(1);
    }
    if (IN(2)) {
        pg8::Gemm g{Hb, (const bf16_t*)(ws + WS_WD1), MT, DM, DFF}; pg8::SplitOrder S; S.init(DM, DFF, 11, G, bid);
        pg8::EpiDown E{Dh, PART};
        pg8::gemm_phase<pg8::EpiDown, pg8::SplitOrder>(lds, g, S, E);
        SEAM(2);
    }
    if (IN(3)) {
        row_phase<1>(p, Dh, PART, 11, Y, XN, p.in[I_G1B], p.in[I_GMA], 0.5f, true);
        if (bid == 0 && threadIdx.x == 0) __hip_atomic_store((unsigned*)(ws + WS_CNT) + 3, 0u, __ATOMIC_RELAXED, __HIP_MEMORY_SCOPE_AGENT);
        SEAM(3);
    }
    if (IN(4)) {
        pg8::Gemm g{XN, (const bf16_t*)(ws + WS_WIN), MT, DIN, DM}; pg8::StaticOrder S; S.init(MT, DIN, DM, G, bid);
        pg8::EpiInProj E{(bf16_t*)(ws + WS_Q), (bf16_t*)(ws + WS_KP), (bf16_t*)(ws + WS_KS), (bf16_t*)(ws + WS_VTP), (bf16_t*)(ws + WS_VTS), (bf16_t*)(ws + WS_GG), (float*)(ws + WS_LX), p.out};
        pg8::gemm_phase<pg8::EpiInProj, pg8::StaticOrder>(lds, g, S, E);
        filler_loop<1>(p, lds, (unsigned*)(ws + WS_CNT) + 3, 0, NCU_ALL);
        SEAM(4);
    }
    if (IN(5)) {
        { LruConst lk; lru_load_const(p, lk);
          for (int it = bid; it < NBP * 128 + NBS; it += G) lru_local_item(p, lds, it, lk); }
        knorm_items(p);
        if (bid == 0 && threadIdx.x < 2) __hip_atomic_store((unsigned*)(ws + WS_CNT) + threadIdx.x, 0u, __ATOMIC_RELAXED, __HIP_MEMORY_SCOPE_AGENT);
        SEAM(5);
    }
    if (IN(6)) {
        const int lane = threadIdx.x & 63;
        const float lam = __expf(wave_sum(p.in[I_LQ1][lane] * p.in[I_LK1][lane])) - __expf(wave_sum(p.in[I_LQ2][lane] * p.in[I_LK2][lane])) + 0.2f;
        if (bid < NBP) lru_carry_scan(p, bid);
        unsigned* qcnt = (unsigned*)(ws + WS_CNT);
        LAS int* slot = (LAS int*)(lds + LDS_CTL);
        constexpr int NQ_S = NBS * 4, NQ_P = NBP * 4 * 64, NQ_L = NBP * 128 + NBS;
        if (threadIdx.x == 0) *slot = (int)atomicAdd(qcnt, 1u);
        __syncthreads();
        for (;;) {
            const int idx = *slot;
            if (idx >= NQ_S + NQ_P + NQ_L) break;
            if (idx < NQ_S + NQ_P) {
                int kind, b, h, qb;
                if (idx < NQ_S) { kind = 1; b = idx & 7; h = 3 - (idx >> 3); qb = 0; }
                else { const int j = idx - NQ_S, r = j & 255; kind = 0; b = r & 3; h = 3 - (j >> 8); qb = 63 - (r >> 2); }
                attn_item(p, lds, kind, b, h, qb, lam, qcnt, slot);
            } else { __syncthreads(); lru_final_item(p, idx - NQ_S - NQ_P); if (threadIdx.x == 0) *slot = (int)atomicAdd(qcnt, 1u); __syncthreads(); }
        }
        SEAM(6);
    }
    if (IN(7)) {
        pg8::Gemm g{XN  , (const bf16_t*)(ws + WS_WOUT), MT, DM, DM}; pg8::SplitOrder S; S.init(DM, DM, 4, G, bid);
        pg8::EpiDown E{Dh, PART};
        pg8::gemm_phase<pg8::EpiDown, pg8::SplitOrder>(lds, g, S, E);
        SEAM(7);
    }
    if (IN(8)) { row_phase<1>(p, Dh, PART, 4, Y, XN, p.in[I_GMB], p.in[I_G2A], 1.0f, false); SEAM(8); }
    if (IN(9)) {
        pg8::Gemm g{XN, (const bf16_t*)(ws + WS_WGU2), MT, 2 * DFF, DM}; pg8::StaticOrder S; S.init(MT, 2 * DFF, DM, G, bid);
        pg8::EpiSwiglu E{Hb};
        pg8::gemm_phase<pg8::EpiSwiglu, pg8::StaticOrder>(lds, g, S, E);
        SEAM(9);
    }
    if (IN(10)) {
        pg8::Gemm g{Hb, (const bf16_t*)(ws + WS_WD2), MT, DM, DFF}; pg8::SplitOrder S; S.init(DM, DFF, 11, G, bid);
        pg8::EpiDown E{Dh, PART};
        pg8::gemm_phase<pg8::EpiDown, pg8::SplitOrder>(lds, g, S, E);
        SEAM(10);
    }
    if (IN(11)) row_phase<2>(p, Dh, PART, 11, Y, nullptr, p.in[I_G2B], nullptr, 0.5f, false);
#undef IN
#undef SEAM
}

constexpr int N_PHASES = 12;
#define LAUNCH_RANGES {0, N_PHASES}

extern "C" void kernel_launch(void* const* d_in, const int* in_sizes, int n_in, void* d_out, int out_size, void* d_ws, size_t ws_size, hipStream_t stream) {
    static int grid_blocks = 0;
    if (grid_blocks == 0) {
        if (n_in != 32 || ws_size < WS_END) { fprintf(stderr, "kernel_launch: need 32 inputs and >= %zu bytes of workspace (got %d, %zu)\n", (size_t)WS_END, n_in, ws_size); grid_blocks = -1; return; }
        int dev = 0, cus = 0, per_cu = 0;
        hipGetDevice(&dev);
        hipDeviceGetAttribute(&cus, hipDeviceAttributeMultiprocessorCount, dev);
        if (hipFuncSetAttribute((const void*)fwd_megakernel, hipFuncAttributeMaxDynamicSharedMemorySize, LDS_BYTES) != hipSuccess) { fprintf(stderr, "kernel_launch: hipFuncSetAttribute failed\n"); grid_blocks = -1; return; }
        if (hipOccupancyMaxActiveBlocksPerMultiprocessor(&per_cu, (const void*)fwd_megakernel, NTHREADS, LDS_BYTES) != hipSuccess || per_cu < 1) { fprintf(stderr, "kernel_launch: occupancy query failed (%d)\n", per_cu); grid_blocks = -1; return; }
        grid_blocks = cus * per_cu;
    }
    if (grid_blocks < 0) return;
    Params p{};
    for (int i = 0; i < 32; ++i) p.in[i] = (const float*)d_in[i];
    p.out = (float*)d_out; p.ws = (unsigned char*)d_ws;
    static const int ranges[][2] = {LAUNCH_RANGES};
    for (unsigned li = 0; li < sizeof(ranges) / sizeof(ranges[0]); ++li) {
        p.ph_lo = ranges[li][0]; p.ph_hi = ranges[li][1];
        if (hipMemsetAsync((unsigned char*)d_ws + WS_BAR, 0, 16384, stream) != hipSuccess) { fprintf(stderr, "kernel_launch: hipMemsetAsync failed\n"); return; }
        void* args[] = {&p};
        hipError_t e = hipLaunchCooperativeKernel((const void*)fwd_megakernel, dim3(grid_blocks), dim3(NTHREADS), args, LDS_BYTES, stream);
        if (e != hipSuccess) fprintf(stderr, "cooperative launch failed: %s (grid %d)\n", hipGetErrorString(e), grid_blocks);
    }
}
```
